# Optimizing an MI355X kernel written in HIP

```python
import jax, jax.numpy as jnp
from jax import lax
import numpy as np

D_MODEL = 1024
BATCH = 4
SEQ = 8192
DEPTH = 2

MIX_WIDTH = D_MODEL
SGU_WIDTH = MIX_WIDTH // 2
MLSTM_WIDTH = MIX_WIDTH - SGU_WIDTH
SGU_HEADS = 4
SGU_HEAD_DIM = SGU_WIDTH // SGU_HEADS
SGU_CHUNK = 128
MLSTM_HEADS = 4
MLSTM_HEAD_DIM = MLSTM_WIDTH // MLSTM_HEADS
MLSTM_CHUNK = 128
QKV_BLOCK = 4
CONV_WIDTH = 5
FFN_HIDDEN = ((8 * D_MODEL // 3 + 255) // 256) * 256
IN_WIDTH = 2 * SGU_WIDTH + 2 * MLSTM_WIDTH
EPS = 1e-6

kernel_name = 'hybrid_gmlp_mlstm_macaron_encoder'


def rms_norm(x, g):
    xf = x.astype(jnp.float32)
    y = xf * lax.rsqrt(jnp.mean(xf * xf, axis=-1, keepdims=True) + EPS)
    return (y * g.astype(jnp.float32)).astype(x.dtype)


def head_layer_norm(x, g):
    xf = x.astype(jnp.float32)
    mu = jnp.mean(xf, axis=-1, keepdims=True)
    var = jnp.mean(jnp.square(xf - mu), axis=-1, keepdims=True)
    y = (xf - mu) * lax.rsqrt(var + EPS) * g.astype(jnp.float32)
    return y.astype(x.dtype)


def swiglu(x, w_gate, w_up, w_down):
    return (jax.nn.silu(x @ w_gate) * (x @ w_up)) @ w_down


def spatial_gating(u, v, g, w_s, b_s):
    B, S, _ = u.shape
    nc = S // SGU_CHUNK
    u = jax.nn.gelu(u)
    v = jax.nn.gelu(v)
    vh = head_layer_norm(v.reshape(B, nc, SGU_CHUNK, SGU_HEADS, SGU_HEAD_DIM), g)
    s = jnp.einsum('hpq,bcqhd->bcphd', w_s, vh) + b_s.T[:, :, None]
    return u * s.reshape(B, S, SGU_WIDTH)


def depthwise_conv(x, w, b):
    C = x.shape[-1]
    pad = CONV_WIDTH // 2
    y = lax.conv_general_dilated(x, w[:, None, :], window_strides=(1,), padding=[(pad, pad)],
                                 dimension_numbers=('NWC', 'WIO', 'NWC'), feature_group_count=C)
    return y + b


def headwise(x, w):
    B, S, C = x.shape
    xb = x.reshape(B, S, C // QKV_BLOCK, QKV_BLOCK)
    return jnp.einsum('bsgi,gio->bsgo', xb, w).reshape(B, S, C)


def mlstm_chunkwise(q, k, v, ig, lf):
    B, S, H, Dh = q.shape
    L = MLSTM_CHUNK
    nc = S // L
    to_chunks = lambda t: t.reshape(B, nc, L, H, Dh).transpose(1, 0, 3, 2, 4)
    g_chunks = lambda t: t.reshape(B, nc, L, H).transpose(1, 0, 3, 2)
    tri = jnp.tril(jnp.ones((L, L), dtype=bool))

    def step(carry, inp):
        C, n, m = carry
        qc, kc, vc, ic, fc = inp
        b = jnp.cumsum(fc, axis=-1)
        d = jnp.where(tri, b[..., :, None] - b[..., None, :] + ic[..., None, :], -jnp.inf)
        inter = b + m[..., None]
        m_j = jnp.maximum(inter, jnp.max(d, axis=-1))
        w_intra = jnp.exp(d - m_j[..., None])
        w_inter = jnp.exp(inter - m_j)
        s = jnp.einsum('bhjd,bhsd->bhjs', qc, kc) * w_intra
        num = (w_inter[..., None] * jnp.einsum('bhvk,bhjk->bhjv', C, qc)
               + jnp.einsum('bhjs,bhsv->bhjv', s, vc))
        nq = w_inter * jnp.einsum('bhk,bhjk->bhj', n, qc) + jnp.sum(s, axis=-1)
        h = num / jnp.maximum(jnp.abs(nq), jnp.exp(-m_j))[..., None]
        b_last = b[..., -1]
        dec = b_last[..., None] - b + ic
        m_new = jnp.maximum(b_last + m, jnp.max(dec, axis=-1))
        wk = jnp.exp(dec - m_new[..., None])
        scale = jnp.exp(b_last + m - m_new)
        C_new = scale[..., None, None] * C + jnp.einsum('bhs,bhsv,bhsk->bhvk', wk, vc, kc)
        n_new = scale[..., None] * n + jnp.einsum('bhs,bhsk->bhk', wk, kc)
        return (C_new, n_new, m_new), h

    init = (jnp.zeros((B, H, Dh, Dh), jnp.float32),
            jnp.zeros((B, H, Dh), jnp.float32),
            jnp.zeros((B, H), jnp.float32))
    _, hs = lax.scan(step, init, (to_chunks(q), to_chunks(k), to_chunks(v), g_chunks(ig), g_chunks(lf)))
    return hs.transpose(1, 0, 3, 2, 4).reshape(B, S, H, Dh)


def mlstm_mixer(xm, og, conv_w, conv_b, w_q, w_k, w_v, gate_w_fwd, gate_b_fwd,
                gate_w_bwd, gate_b_bwd, mh_norm, skip):
    B, S, _ = xm.shape
    H, Dh = MLSTM_HEADS, MLSTM_HEAD_DIM
    xc = jax.nn.silu(depthwise_conv(xm, conv_w, conv_b))
    q = headwise(xc, w_q)
    k = headwise(xc, w_k) * (Dh ** -0.5)
    v = headwise(xm, w_v)
    qkv = jnp.concatenate([q, k, v], axis=-1)

    def gates(w, b):
        g = (qkv @ w + b).astype(jnp.float32)
        return g[..., :H], jax.nn.log_sigmoid(g[..., H:])

    qh = q.reshape(B, S, H, Dh).astype(jnp.float32)
    kh = k.reshape(B, S, H, Dh).astype(jnp.float32)
    vh = v.reshape(B, S, H, Dh).astype(jnp.float32)
    ig_f, lf_f = gates(gate_w_fwd, gate_b_fwd)
    ig_b, lf_b = gates(gate_w_bwd, gate_b_bwd)
    h_fwd = mlstm_chunkwise(qh, kh, vh, ig_f, lf_f)
    flip = lambda t: jnp.flip(t, axis=1)
    h_bwd = flip(mlstm_chunkwise(flip(qh), flip(kh), flip(vh), flip(ig_b), flip(lf_b)))
    hn = head_layer_norm(h_fwd + h_bwd, mh_norm).reshape(B, S, MLSTM_WIDTH).astype(xm.dtype)
    return (hn + skip * xc) * jax.nn.sigmoid(og)


def setup_inputs(seed: int = 0) -> dict:
    key = jax.random.key(seed)
    ks = iter(jax.random.split(key, 40))
    nrm = lambda shape, scale: jax.random.normal(next(ks), shape, jnp.float32) * scale
    gain = lambda shape: 1.0 + nrm(shape, 0.02)
    H = MLSTM_HEADS

    def gate_bias():
        ib = nrm((DEPTH, H), 0.1)
        fb = jnp.linspace(3.0, 6.0, H, dtype=jnp.float32)[None, :] + nrm((DEPTH, H), 0.01)
        return jnp.concatenate([ib, fb], axis=-1)

    return {
        'x': nrm((BATCH, SEQ, D_MODEL), 1.0),
        'ffn1_norm': gain((DEPTH, D_MODEL)),
        'ffn1_w_gate': nrm((DEPTH, D_MODEL, FFN_HIDDEN), D_MODEL ** -0.5),
        'ffn1_w_up': nrm((DEPTH, D_MODEL, FFN_HIDDEN), D_MODEL ** -0.5),
        'ffn1_w_down': nrm((DEPTH, FFN_HIDDEN, D_MODEL), FFN_HIDDEN ** -0.5),
        'mix_norm': gain((DEPTH, D_MODEL)),
        'w_in': nrm((DEPTH, D_MODEL, IN_WIDTH), D_MODEL ** -0.5),
        'sgu_norm': gain((DEPTH, SGU_HEADS, SGU_HEAD_DIM)),
        'sgu_w': nrm((DEPTH, SGU_HEADS, SGU_CHUNK, SGU_CHUNK), 0.5 * SGU_CHUNK ** -0.5),
        'sgu_b': 1.0 + nrm((DEPTH, SGU_HEADS, SGU_CHUNK), 0.1),
        'conv_w': nrm((DEPTH, CONV_WIDTH, MLSTM_WIDTH), CONV_WIDTH ** -0.5),
        'conv_b': nrm((DEPTH, MLSTM_WIDTH), 0.02),
        'w_q': nrm((DEPTH, MLSTM_WIDTH // QKV_BLOCK, QKV_BLOCK, QKV_BLOCK), QKV_BLOCK ** -0.5),
        'w_k': nrm((DEPTH, MLSTM_WIDTH // QKV_BLOCK, QKV_BLOCK, QKV_BLOCK), QKV_BLOCK ** -0.5),
        'w_v': nrm((DEPTH, MLSTM_WIDTH // QKV_BLOCK, QKV_BLOCK, QKV_BLOCK), QKV_BLOCK ** -0.5),
        'gate_w_fwd': nrm((DEPTH, 3 * MLSTM_WIDTH, 2 * H), 0.1 * (3 * MLSTM_WIDTH) ** -0.5),
        'gate_b_fwd': gate_bias(),
        'gate_w_bwd': nrm((DEPTH, 3 * MLSTM_WIDTH, 2 * H), 0.1 * (3 * MLSTM_WIDTH) ** -0.5),
        'gate_b_bwd': gate_bias(),
        'mh_norm': gain((DEPTH, MLSTM_HEADS, MLSTM_HEAD_DIM)),
        'mlstm_skip': gain((DEPTH, MLSTM_WIDTH)),
        'w_out': nrm((DEPTH, MIX_WIDTH, D_MODEL), MIX_WIDTH ** -0.5),
        'ffn2_norm': gain((DEPTH, D_MODEL)),
        'ffn2_w_gate': nrm((DEPTH, D_MODEL, FFN_HIDDEN), D_MODEL ** -0.5),
        'ffn2_w_up': nrm((DEPTH, D_MODEL, FFN_HIDDEN), D_MODEL ** -0.5),
        'ffn2_w_down': nrm((DEPTH, FFN_HIDDEN, D_MODEL), FFN_HIDDEN ** -0.5),
        'final_norm': gain((D_MODEL,)),
    }


def reference(x, ffn1_norm, ffn1_w_gate, ffn1_w_up, ffn1_w_down, mix_norm, w_in,
              sgu_norm, sgu_w, sgu_b, conv_w, conv_b, w_q, w_k, w_v,
              gate_w_fwd, gate_b_fwd, gate_w_bwd, gate_b_bwd, mh_norm, mlstm_skip, w_out,
              ffn2_norm, ffn2_w_gate, ffn2_w_up, ffn2_w_down, final_norm):
    split_at = [SGU_WIDTH, 2 * SGU_WIDTH, 2 * SGU_WIDTH + MLSTM_WIDTH]
    for l in range(DEPTH):
        h = x + 0.5 * swiglu(rms_norm(x, ffn1_norm[l]), ffn1_w_gate[l], ffn1_w_up[l], ffn1_w_down[l])
        z = rms_norm(h, mix_norm[l]) @ w_in[l]
        u, v, xm, og = jnp.split(z, split_at, axis=-1)
        y_sgu = spatial_gating(u, v, sgu_norm[l], sgu_w[l], sgu_b[l])
        y_mlstm = mlstm_mixer(xm, og, conv_w[l], conv_b[l], w_q[l], w_k[l], w_v[l],
                              gate_w_fwd[l], gate_b_fwd[l], gate_w_bwd[l], gate_b_bwd[l],
                              mh_norm[l], mlstm_skip[l])
        h = h + jnp.concatenate([y_sgu, y_mlstm], axis=-1) @ w_out[l]
        x = h + 0.5 * swiglu(rms_norm(h, ffn2_norm[l]), ffn2_w_gate[l], ffn2_w_up[l], ffn2_w_down[l])
    return rms_norm(x, final_norm)
```

```cpp
#include <hip/hip_runtime.h>
#include <hip/hip_cooperative_groups.h>
#include <cstdio>
namespace cg = cooperative_groups;
#ifndef GEMM_SP2
#define GEMM_SP2 true
#endif
#ifndef GEMM_ALIGN
#define GEMM_ALIGN true
#endif
constexpr int GRID = 256;

typedef unsigned short bf16_t;
typedef short bf16x8 __attribute__((ext_vector_type(8)));
typedef float f32x4 __attribute__((ext_vector_type(4)));
typedef unsigned u32x4 __attribute__((ext_vector_type(4)));
typedef unsigned u32x2 __attribute__((ext_vector_type(2)));

__device__ __forceinline__ int l_tid() { int t = threadIdx.x; asm volatile("" : "+v"(t)); return t; }
__device__ __forceinline__ int l_bid() { int t = blockIdx.x; asm volatile("" : "+s"(t)); return t; }

namespace pg8 {
#define PG8_LAS __attribute__((address_space(3)))
constexpr int BM = 256, BK = 64, HALF = 128, HTB = HALF * BK * 2  , STAGE_BYTES = 8 * HTB, NXCD = 8, WGM = 8;

__host__ __device__ __forceinline__ int lds_byte(int r, int c) { const int st = (r >> 4) * 2 + (c >> 5), rr = r & 15, cc = c & 31, ob = rr * 64 + cc * 2; return st * 1024 + (ob ^ (((ob >> 9) & 1) << 5)); }
__host__ __device__ __forceinline__ void stage_rc(int b, int& R, int& C) { const int st = b / 1024, sb = b % 1024, swz = sb ^ (((sb >> 9) & 1) << 5); R = (st >> 1) * 16 + swz / 64; C = (st & 1) * 32 + (swz % 64) / 2; }
__host__ __device__ __forceinline__ int perm32(int rho) { const int n = rho >> 4, i = rho & 15; return 8 * (i >> 2) + 4 * n + (i & 3); }

struct Unit { int pm, pn; };
struct Gemm { const bf16_t* A; const bf16_t* Bt; int M, N, K; };

struct StaticOrder {
    int nM, nN, nwg, G, c;
    __host__ __device__ void init(int M, int N, int G_, int c_) { nM = M / BM; nN = N / BM; nwg = nM * nN; G = G_; c = c_; }
    __host__ __device__ bool next(int i, Unit& u) const {
        const long L = (long)i * G + c; if (L >= nwg) return false;
        int wgid = (int)L; { const int q = nwg / NXCD, r = nwg % NXCD, xcd = wgid % NXCD, off = wgid / NXCD; wgid = (xcd < r ? xcd * (q + 1) : r * (q + 1) + (xcd - r) * q) + off; }
        const int nig = WGM * nN, gid = wgid / nig, fm = gid * WGM, gsz = (nM - fm) < WGM ? (nM - fm) : WGM;
        u.pm = fm + ((wgid % nig) % gsz); u.pn = (wgid % nig) / gsz; return true;
    }
    __device__ __forceinline__ void a_ready(const Unit&) const {}
    __device__ __forceinline__ void done(const Unit&) const {}
};

template <class Epi, class Sched, bool ALIGN_EPI = false, bool SP2 = false>
__device__ __forceinline__ void gemm_phase(PG8_LAS unsigned char* lds, const Gemm g, const Sched& S, const Epi& E) {
    const int tid = l_tid(), wid = __builtin_amdgcn_readfirstlane(tid >> 6), lane = tid & 63, wr = wid >> 2, wc = wid & 3, fr = lane & 15, fq = lane >> 4;
    const int K = g.K, nt = K / BK;
    unsigned voffA[2], voffB[2];
#pragma unroll
    for (int i = 0; i < 2; ++i) { int R, C; stage_rc(tid * 16 + i * 8192, R, C); const int Rb = Epi::PERM ? ((R & ~31) + perm32(R & 31)) : R;
        voffA[i] = (unsigned)(R * K + C) * 2u; voffB[i] = (unsigned)(Rb * K + C) * 2u; }
    const size_t kstep = (size_t)(BK * 2);
    const size_t hstep = (size_t)HALF * K * 2;
    const size_t tstep = 2 * hstep;
    const unsigned ldsw = (unsigned)wid * 1024u;
    const int aoff = lds_byte(wr * 64 + fr, fq * 8), boff = lds_byte(wc * 32 + fr, fq * 8);
#define PG8_SA(b, h) (((b) * 2 + (h)) * HTB)
#define PG8_SB(b, h) ((4 + (b) * 2 + (h)) * HTB)
#define PG8_STAGE(bufoff, gbase, voff) do { _Pragma("unroll") for (int _i = 0; _i < 2; ++_i) \
        __builtin_amdgcn_global_load_lds((const unsigned*)((const char*)(gbase) + (voff)[_i]), (PG8_LAS unsigned*)(lds + (bufoff) + ldsw + _i * 8192), 16, 0, 0); } while (0)
#define PG8_LDA(dst, b, h) do { _Pragma("unroll") for (int m = 0; m < 4; ++m) _Pragma("unroll") for (int k = 0; k < 2; ++k) dst[m][k] = *(const PG8_LAS bf16x8*)(lds + PG8_SA(b, h) + aoff + m * 2048 + k * 1024); } while (0)
#define PG8_LDB(dst, b, h) do { _Pragma("unroll") for (int n = 0; n < 2; ++n) _Pragma("unroll") for (int k = 0; k < 2; ++k) dst[n][k] = *(const PG8_LAS bf16x8*)(lds + PG8_SB(b, h) + boff + n * 2048 + k * 1024); } while (0)
#define PG8_MMA(ai, bj, At, Bt) do { __builtin_amdgcn_s_setprio(1); _Pragma("unroll") for (int m = 0; m < 4; ++m) _Pragma("unroll") for (int n = 0; n < 2; ++n) _Pragma("unroll") for (int k = 0; k < 2; ++k) \
        acc[ai][bj][m][n] = __builtin_amdgcn_mfma_f32_16x16x32_bf16(Bt[n][k], At[m][k], acc[ai][bj][m][n], 0, 0, 0); __builtin_amdgcn_s_setprio(0); } while (0)
#define PG8_WAIT_V(n) asm volatile("s_waitcnt vmcnt(" #n ")" ::: "memory")
#define PG8_WAIT_L(n) asm volatile("s_waitcnt lgkmcnt(" #n ")" ::: "memory")
#define PG8_BAR __builtin_amdgcn_s_barrier()
#define PG8_SCHED __builtin_amdgcn_sched_barrier(0)
    Unit cur, nxt; int ui = 0;
    if (!S.next(0, cur)) return;
    f32x4 acc[2][2][4][2];
#pragma unroll
    for (int a = 0; a < 2; ++a)
#pragma unroll
        for (int b = 0; b < 2; ++b)
#pragma unroll
            for (int m = 0; m < 4; ++m)
#pragma unroll
                for (int n = 0; n < 2; ++n) acc[a][b][m][n] = (f32x4){0.f, 0.f, 0.f, 0.f};
    bf16x8 At[4][2], B0[2][2], B1[2][2];
    const char* cA = (const char*)g.A + (size_t)cur.pm * tstep; const char* cB = (const char*)g.Bt + (size_t)cur.pn * tstep;
    S.a_ready(cur);
    if constexpr (SP2) {
        PG8_STAGE(PG8_SB(0, 0), cB, voffB); PG8_STAGE(PG8_SB(0, 1), cB + hstep, voffB); PG8_STAGE(PG8_SA(0, 0), cA, voffA); PG8_STAGE(PG8_SA(0, 1), cA + hstep, voffA);
        if (wr == 1) PG8_BAR;
        PG8_WAIT_V(2); PG8_BAR;
        PG8_STAGE(PG8_SB(1, 0), cB + kstep, voffB); PG8_STAGE(PG8_SA(1, 0), cA + kstep, voffA); PG8_STAGE(PG8_SB(1, 1), cB + hstep + kstep, voffB);
        PG8_WAIT_V(6); PG8_BAR;
    } else {
        PG8_STAGE(PG8_SB(0, 0), cB, voffB); PG8_STAGE(PG8_SA(0, 0), cA, voffA); PG8_STAGE(PG8_SB(0, 1), cB + hstep, voffB); PG8_STAGE(PG8_SA(0, 1), cA + hstep, voffA);
        if (wr == 1) PG8_BAR;
        PG8_WAIT_V(4); PG8_BAR;
        PG8_STAGE(PG8_SB(1, 0), cB + kstep, voffB); PG8_STAGE(PG8_SA(1, 0), cA + kstep, voffA); PG8_STAGE(PG8_SB(1, 1), cB + hstep + kstep, voffB);
        PG8_WAIT_V(6); PG8_BAR;
    }
    for (;;) {
        const bool has_next = S.next(ui + 1, nxt);
        const char* nA = has_next ? (const char*)g.A + (size_t)nxt.pm * tstep : cA; const char* nB = has_next ? (const char*)g.Bt + (size_t)nxt.pn * tstep : cB;
        for (int t = 0; t < nt; t += 2) {
            const bool last = (t == nt - 2);
            const char* a1 = cA + (size_t)(t + 1) * kstep;
            const char* a2 = last ? nA : cA + (size_t)(t + 2) * kstep; const char* b2 = last ? nB : cB + (size_t)(t + 2) * kstep;
            const char* a3 = a2 + kstep; const char* b3 = b2 + kstep;
            if (last && has_next) S.a_ready(nxt);
            if constexpr (SP2) {
            PG8_LDB(B0, 0, 0); PG8_LDB(B1, 0, 1); PG8_SCHED; PG8_LDA(At, 0, 0); PG8_STAGE(PG8_SA(1, 1), a1 + hstep, voffA);
            PG8_WAIT_V(8); PG8_WAIT_L(0); PG8_BAR; PG8_MMA(0, 0, At, B0); PG8_MMA(0, 1, At, B1); PG8_BAR; PG8_SCHED;
            PG8_LDA(At, 0, 1); PG8_STAGE(PG8_SB(0, 0), b2, voffB); PG8_STAGE(PG8_SB(0, 1), b2 + hstep, voffB); PG8_STAGE(PG8_SA(0, 0), a2, voffA);
            PG8_WAIT_V(8); PG8_WAIT_L(0); PG8_BAR; PG8_MMA(1, 0, At, B0); PG8_MMA(1, 1, At, B1); PG8_BAR; PG8_SCHED;
            PG8_LDB(B0, 1, 0); PG8_LDB(B1, 1, 1); PG8_SCHED; PG8_LDA(At, 1, 0); PG8_STAGE(PG8_SA(0, 1), a2 + hstep, voffA);
            PG8_WAIT_V(8); PG8_WAIT_L(0); PG8_BAR; PG8_MMA(0, 0, At, B0); PG8_MMA(0, 1, At, B1); PG8_BAR; PG8_SCHED;
            PG8_LDA(At, 1, 1); PG8_STAGE(PG8_SB(1, 0), b3, voffB); PG8_STAGE(PG8_SB(1, 1), b3 + hstep, voffB); PG8_STAGE(PG8_SA(1, 0), a3, voffA);
            PG8_WAIT_V(8); PG8_WAIT_L(0); PG8_BAR; PG8_MMA(1, 0, At, B0); PG8_MMA(1, 1, At, B1); PG8_BAR; PG8_SCHED;
            } else {
            PG8_LDB(B0, 0, 0); PG8_SCHED; PG8_LDA(At, 0, 0); PG8_STAGE(PG8_SA(1, 1), a1 + hstep, voffA);
            PG8_WAIT_L(8); PG8_BAR; PG8_WAIT_L(0); PG8_MMA(0, 0, At, B0); PG8_BAR; PG8_SCHED;
            PG8_LDB(B1, 0, 1); PG8_STAGE(PG8_SB(0, 0), b2, voffB);
            PG8_BAR; PG8_WAIT_L(0); PG8_MMA(0, 1, At, B1); PG8_BAR;
            PG8_LDA(At, 0, 1); PG8_STAGE(PG8_SA(0, 0), a2, voffA);
            PG8_BAR; PG8_WAIT_L(0); PG8_MMA(1, 0, At, B0); PG8_BAR; PG8_SCHED;
            PG8_STAGE(PG8_SB(0, 1), b2 + hstep, voffB);
            PG8_WAIT_V(6); PG8_BAR; PG8_MMA(1, 1, At, B1); PG8_BAR;
            PG8_LDB(B0, 1, 0); PG8_SCHED; PG8_LDA(At, 1, 0); PG8_STAGE(PG8_SA(0, 1), a2 + hstep, voffA);
            PG8_WAIT_L(8); PG8_BAR; PG8_WAIT_L(0); PG8_MMA(0, 0, At, B0); PG8_BAR; PG8_SCHED;
            PG8_LDB(B1, 1, 1); PG8_STAGE(PG8_SB(1, 0), b3, voffB);
            PG8_BAR; PG8_WAIT_L(0); PG8_MMA(0, 1, At, B1); PG8_BAR;
            PG8_LDA(At, 1, 1); PG8_STAGE(PG8_SA(1, 0), a3, voffA);
            PG8_BAR; PG8_WAIT_L(0); PG8_MMA(1, 0, At, B0); PG8_BAR; PG8_SCHED;
            PG8_STAGE(PG8_SB(1, 1), b3 + hstep, voffB);
            PG8_WAIT_V(6); PG8_BAR; PG8_MMA(1, 1, At, B1); PG8_BAR;
            }
        }
        if constexpr (ALIGN_EPI) { if (wr == 0) PG8_BAR; }
        if constexpr (!Epi::AFTER_DRAIN) { E(acc, cur, wr, wc, fr, fq); S.done(cur); }
        if (!has_next) break;
#pragma unroll
        for (int a = 0; a < 2; ++a)
#pragma unroll
            for (int b = 0; b < 2; ++b)
#pragma unroll
                for (int m = 0; m < 4; ++m)
#pragma unroll
                    for (int n = 0; n < 2; ++n) acc[a][b][m][n] = (f32x4){0.f, 0.f, 0.f, 0.f};
        cur = nxt; cA = nA; cB = nB; ++ui;
        if constexpr (ALIGN_EPI) { if (wr == 1) PG8_BAR; }
    }
    PG8_WAIT_V(0);
    if constexpr (!ALIGN_EPI) { if (wr == 0) PG8_BAR; }
    PG8_BAR;
    if constexpr (Epi::AFTER_DRAIN) { E.fused(acc, cur, wr, wc, fr, fq, lds, wid, lane); S.done(cur); }
#undef PG8_SA
#undef PG8_SB
#undef PG8_STAGE
#undef PG8_LDA
#undef PG8_LDB
#undef PG8_MMA
#undef PG8_WAIT_V
#undef PG8_WAIT_L
#undef PG8_BAR
#undef PG8_SCHED
}
}

#define XB_TMO      128
#define XB_XCNT(j)  (256  + 64 * (j))
#define XB_XSUB(j)  (1280 + 64 * (j))
#define XB_XGEN(j)  (2304 + 64 * (j))
#define XB_TOP      3328
#define XB_TOPGEN   3392
#define XCD_BAR_WORDS 3456
#define XB_SPIN_CAP (1u << 18)
#define LAS __attribute__((address_space(3)))

__device__ __forceinline__ unsigned xb_ld(unsigned* p)              { return __hip_atomic_load(p, __ATOMIC_RELAXED, __HIP_MEMORY_SCOPE_AGENT); }
__device__ __forceinline__ unsigned xb_add(unsigned* p, unsigned v) { return __hip_atomic_fetch_add(p, v, __ATOMIC_RELAXED, __HIP_MEMORY_SCOPE_AGENT); }
__device__ __forceinline__ unsigned xb_xcc_id() { return (unsigned)__builtin_amdgcn_s_getreg((3 << 11) | 20) & 0xFu; }
#define XB_SPIN(cond, bar) do { unsigned _sp = 0; while (cond) { __builtin_amdgcn_s_sleep(1); \
    if ((++_sp & 255u) == 0u) { if (xb_ld(&(bar)[XB_TMO])) break; if (_sp > XB_SPIN_CAP) { atomicAdd(&(bar)[XB_TMO], 1u); break; } } } } while (0)

struct XcdBarrier {
    unsigned* bar; unsigned x;
    volatile LAS unsigned* st;
};

__device__ __forceinline__ XcdBarrier xcd_barrier_post(unsigned* bar, volatile LAS unsigned* st) {
    XcdBarrier b; b.bar = bar; b.x = xb_xcc_id(); b.st = st;
    if (threadIdx.x == 0) (void)xb_add(&bar[XB_XCNT(b.x)], 1u);
    return b;
}
__device__ __forceinline__ void xcd_barrier_complete(unsigned* bar, unsigned x, unsigned& nloc, unsigned& nx) {
    const unsigned G = GRID;
    unsigned sum, cnt, mine, sp = 0u;
    for (;;) {
        sum = 0u; cnt = 0u; mine = 0u;
#pragma unroll
        for (unsigned j = 0; j < 16; ++j) { const unsigned c = xb_ld(&bar[XB_XCNT(j)]); sum += c; cnt += (c > 0u) ? 1u : 0u; mine = (j == x) ? c : mine; }
        if (sum == G) break;
        __builtin_amdgcn_s_sleep(1);
        if ((++sp & 255u) == 0u) { if (xb_ld(&bar[XB_TMO])) break; if (sp > XB_SPIN_CAP) { atomicAdd(&bar[XB_TMO], 1u); break; } }
    }
    nloc = mine > 0u ? mine : 1u; nx = cnt > 0u ? cnt : 1u;
}

__device__ __forceinline__ void xcd_barrier(const XcdBarrier& b) {
    asm volatile("s_waitcnt vmcnt(0)" ::: "memory");
    __syncthreads();
    if (threadIdx.x == 0) {
        unsigned* bar = b.bar;
        __builtin_amdgcn_s_waitcnt(0);
        unsigned nloc = b.st[0], nx = b.st[1];
        if (nloc == 0u) { xcd_barrier_complete(bar, b.x, nloc, nx); b.st[0] = nloc; b.st[1] = nx; }
        const unsigned old = xb_add(&bar[XB_XSUB(b.x)], 1u);
        const unsigned gen = old / nloc;
        if (old + 1u == (gen + 1u) * nloc) {
            __builtin_amdgcn_fence(__ATOMIC_RELEASE, "agent");
            asm volatile("s_waitcnt vmcnt(0)" ::: "memory");
            const unsigned og = xb_add(&bar[XB_TOP], 1u);
            const unsigned tg = og / nx;
            if (og + 1u == (tg + 1u) * nx) xb_add(&bar[XB_TOPGEN], 1u);
            else XB_SPIN(xb_ld(&bar[XB_TOPGEN]) == tg, bar);
            __builtin_amdgcn_fence(__ATOMIC_ACQUIRE, "agent");
            xb_add(&bar[XB_XGEN(b.x)], 1u);
            asm volatile("s_waitcnt vmcnt(0)" ::: "memory");
        } else {
            XB_SPIN(xb_ld(&bar[XB_XGEN(b.x)]) == gen, bar);
            __builtin_amdgcn_fence(__ATOMIC_ACQUIRE, "agent");
            asm volatile("s_waitcnt vmcnt(0)" ::: "memory");
        }
    }
    __syncthreads();
}


constexpr int T_TOK = 32768, DM = 1024, FF = 2816, SEQ = 8192, NCH = 64;
constexpr float EPSN = 1e-6f;
constexpr int MP = 272;
constexpr int MBUF = 128 * MP;
constexpr int LDS_MAIN = 4 * MBUF + 8192;
constexpr int LDS_BYTES = LDS_MAIN + 16;

constexpr size_t SZ_WGU = (size_t)2 * FF * DM * 2, SZ_WD = (size_t)DM * FF * 2, SZ_WIN = (size_t)2048 * DM * 2, SZ_WOUT = (size_t)DM * DM * 2;
constexpr size_t SZ_SGUW = (size_t)4 * 128 * 128 * 2, SZ_WGT = (size_t)16 * 1536 * 2;
constexpr size_t LW_GU1 = 0, LW_D1 = LW_GU1 + SZ_WGU, LW_IN = LW_D1 + SZ_WD, LW_OUT = LW_IN + SZ_WIN, LW_GU2 = LW_OUT + SZ_WOUT, LW_D2 = LW_GU2 + SZ_WGU,
                 LW_SGU = LW_D2 + SZ_WD, LW_GT = LW_SGU + SZ_SGUW, LW_END = LW_GT + SZ_WGT;
constexpr size_t WS_W = 0;
constexpr size_t WS_XB = WS_W + 2 * LW_END;
constexpr size_t WS_U = WS_XB + (size_t)T_TOK * DM * 2;
constexpr size_t WS_ZUV = WS_U, WS_ZXO = WS_ZUV + (size_t)T_TOK * 1024 * 2, WS_Q = WS_ZXO + (size_t)T_TOK * 1024 * 2,
                 WS_K = WS_Q + (size_t)T_TOK * 512 * 2, WS_V = WS_K + (size_t)T_TOK * 512 * 2, WS_XC = WS_V + (size_t)T_TOK * 512 * 2,
                 WS_UEND = WS_XC + (size_t)T_TOK * 512 * 2;
static_assert(WS_UEND - WS_U >= (size_t)T_TOK * FF * 2, "H must fit the shared region");
constexpr size_t WS_SSQ = WS_UEND;
constexpr size_t WS_BV = WS_SSQ + (size_t)7 * T_TOK * 16 * 4, WS_AV = WS_BV + (size_t)2048 * 128 * 4, WS_CM = WS_AV + (size_t)2048 * 128 * 4,
                 WS_DN = WS_CM + (size_t)2048 * 128 * 4, WS_SC = WS_DN + (size_t)2048 * 128 * 4, WS_MS = WS_SC + (size_t)2048 * 2 * 4,
                 WS_BAR = WS_MS + (size_t)2048 * 4, WS_CS = (WS_BAR + (size_t)XCD_BAR_WORDS * 4 + 255) / 256 * 256,
                 WS_END = WS_CS + (size_t)2048 * 16384 * 2;

struct Params {
    const float* in[27];
    float* out;
    unsigned char* ws;
    int ph_lo, ph_hi;
};

typedef __bf16 bf16x2_t __attribute__((ext_vector_type(2)));
typedef float f32x2_t __attribute__((ext_vector_type(2)));
__device__ __forceinline__ unsigned pk2(float lo, float hi) { const f32x2_t v = {lo, hi}; const bf16x2_t b = __builtin_convertvector(v, bf16x2_t); return __builtin_bit_cast(unsigned, b); }
__device__ __forceinline__ float bflo(unsigned w) { return __uint_as_float(w << 16); }
__device__ __forceinline__ float bfhi(unsigned w) { return __uint_as_float(w & 0xffff0000u); }
__device__ __forceinline__ float bfel(const u32x4& v, int e) { const unsigned w = v[e >> 1]; return (e & 1) ? bfhi(w) : bflo(w); }
__device__ __forceinline__ float sigmoidf_(float x) { return __builtin_amdgcn_rcpf(1.f + __expf(-x)); }
__device__ __forceinline__ float gelu_tanh(float x) { const float y = 0.7978845608028654f * (x + 0.044715f * x * x * x); return x * __builtin_amdgcn_rcpf(1.f + __expf(-2.f * y)); }
__device__ __forceinline__ float logsig(float x) { return fminf(x, 0.f) - log1pf(expf(-fabsf(x))); }
__device__ __forceinline__ float wave_sum(float v) {
#pragma unroll
    for (int o = 1; o < 64; o <<= 1) v += __shfl_xor(v, o);
    return v;
}

__device__ __forceinline__ float row_ssq(const float* part, int row) {
    const f32x4* q = (const f32x4*)(part + (size_t)row * 16);
    const f32x4 a = q[0], b = q[1], c = q[2], d = q[3];
    return (((a[0] + a[1]) + (a[2] + a[3])) + ((b[0] + b[1]) + (b[2] + b[3]))) + (((c[0] + c[1]) + (c[2] + c[3])) + ((d[0] + d[1]) + (d[2] + d[3])));
}
__device__ __forceinline__ void wave_gemm128(f32x4 (&acc)[8], const unsigned char* Arows, const unsigned char* Brows, int fr, int fq) {
#pragma unroll
    for (int kk = 0; kk < 4; ++kk) {
        const bf16x8 a = *(const bf16x8*)(Arows + fr * MP + kk * 64 + fq * 16);
#pragma unroll
        for (int n = 0; n < 8; ++n) {
            const bf16x8 b = *(const bf16x8*)(Brows + (n * 16 + fr) * MP + kk * 64 + fq * 16);
            acc[n] = __builtin_amdgcn_mfma_f32_16x16x32_bf16(b, a, acc[n], 0, 0, 0);
        }
    }
}
__device__ __forceinline__ void zero8(f32x4 (&acc)[8]) {
#pragma unroll
    for (int n = 0; n < 8; ++n) acc[n] = (f32x4){0.f, 0.f, 0.f, 0.f};
}
__device__ __forceinline__ void load_tile(unsigned char* dst, const bf16_t* src, size_t gp, int tid) {
#pragma unroll
    for (int i = 0; i < 4; ++i) { const int id = tid + 512 * i, row = id >> 4, cc = id & 15;
        *(u32x4*)(dst + row * MP + cc * 16) = *(const u32x4*)(src + (size_t)row * gp + cc * 8); }
}

struct EpiUp {
    static constexpr bool PERM = true, AFTER_DRAIN = false;
    bf16_t* H; const PG8_LAS float* rs; int pm0;
    __device__ __forceinline__ void operator()(const f32x4 (&acc)[2][2][4][2], const pg8::Unit& u, int wr, int wc, int fr, int fq) const {
        const int row0 = u.pm * 256 + wr * 64 + fr, col = u.pn * 128 + wc * 32 + 8 * fq;
#pragma unroll
        for (int ai = 0; ai < 2; ++ai)
#pragma unroll
            for (int m = 0; m < 4; ++m) {
                const int row = row0 + ai * 128 + m * 16;
                const float rstd = rs[((u.pm - pm0) >> 3) * 256 + (row & 255)];
                float h[8];
#pragma unroll
                for (int n = 0; n < 2; ++n)
#pragma unroll
                    for (int i = 0; i < 4; ++i) { const float g = acc[ai][0][m][n][i] * rstd, uu = acc[ai][1][m][n][i] * rstd; h[4 * n + i] = g * uu * __builtin_amdgcn_rcpf(1.f + __expf(-g)); }
                u32x4 o; o[0] = pk2(h[0], h[1]); o[1] = pk2(h[2], h[3]); o[2] = pk2(h[4], h[5]); o[3] = pk2(h[6], h[7]);
                *(u32x4*)(H + (size_t)row * FF + col) = o;
            }
    }
};
template <bool RIN_F32> struct EpiRes {
    static constexpr bool PERM = true, AFTER_DRAIN = false;
    const float* Rin; bf16_t* XB; float* ssq; float scale;
    __device__ __forceinline__ void operator()(const f32x4 (&acc)[2][2][4][2], const pg8::Unit& u, int wr, int wc, int fr, int fq) const {
        static_assert(!RIN_F32, "the residual stream is bf16");
        const int row0 = u.pm * 256 + wr * 64 + fr, col0 = u.pn * 256 + wc * 32 + 8 * fq;
        u32x4 rb[4][2], ob[4][2];
#pragma unroll
        for (int m = 0; m < 4; ++m)
#pragma unroll
            for (int bj = 0; bj < 2; ++bj) rb[m][bj] = *(const u32x4*)(XB + (size_t)(row0 + m * 16) * DM + col0 + bj * 128);
#pragma unroll
        for (int ai = 0; ai < 2; ++ai) {
            float ssv[4];
#pragma unroll
            for (int m = 0; m < 4; ++m) {
                float ss = 0.f;
#pragma unroll
                for (int bj = 0; bj < 2; ++bj) {
                    const u32x4 t = rb[m][bj];
                    const f32x4 r0 = {bflo(t[0]), bfhi(t[0]), bflo(t[1]), bfhi(t[1])}, r1 = {bflo(t[2]), bfhi(t[2]), bflo(t[3]), bfhi(t[3])};
                    const f32x4 v0 = r0 + acc[ai][bj][m][0] * scale, v1 = r1 + acc[ai][bj][m][1] * scale;
                    u32x4 o; o[0] = pk2(v0[0], v0[1]); o[1] = pk2(v0[2], v0[3]); o[2] = pk2(v1[0], v1[1]); o[3] = pk2(v1[2], v1[3]);
                    ob[m][bj] = o;
                    ss += v0[0] * v0[0] + v0[1] * v0[1] + v0[2] * v0[2] + v0[3] * v0[3] + v1[0] * v1[0] + v1[1] * v1[1] + v1[2] * v1[2] + v1[3] * v1[3];
                }
                ss += __shfl_xor(ss, 16); ss += __shfl_xor(ss, 32);
                ssv[m] = ss;
            }
            if (ai == 0) {
#pragma unroll
                for (int m = 0; m < 4; ++m)
#pragma unroll
                    for (int bj = 0; bj < 2; ++bj) rb[m][bj] = *(const u32x4*)(XB + (size_t)(row0 + 128 + m * 16) * DM + col0 + bj * 128);
            }
#pragma unroll
            for (int m = 0; m < 4; ++m) {
                const int row = row0 + ai * 128 + m * 16;
#pragma unroll
                for (int bj = 0; bj < 2; ++bj) *(u32x4*)(XB + (size_t)row * DM + col0 + bj * 128) = ob[m][bj];
                if (fq == 0) ssq[(size_t)row * 16 + u.pn * 4 + wc] = ssv[m];
            }
        }
    }
};
struct EpiWin {
    static constexpr bool PERM = true, AFTER_DRAIN = false;
    bf16_t* ZUV; bf16_t* ZXO; const PG8_LAS float* rs; int pm0;
    __device__ __forceinline__ void operator()(const f32x4 (&acc)[2][2][4][2], const pg8::Unit& u, int wr, int wc, int fr, int fq) const {
        const bool act = u.pn < 4; bf16_t* dst = act ? ZUV : ZXO;
        const int row0 = u.pm * 256 + wr * 64 + fr, col0 = (u.pn & 3) * 256 + wc * 32 + 8 * fq;
#pragma unroll
        for (int ai = 0; ai < 2; ++ai)
#pragma unroll
            for (int m = 0; m < 4; ++m) {
                const int row = row0 + ai * 128 + m * 16;
                const float rstd = rs[((u.pm - pm0) >> 3) * 256 + (row & 255)];
#pragma unroll
                for (int bj = 0; bj < 2; ++bj) {
                    float h[8];
#pragma unroll
                    for (int n = 0; n < 2; ++n)
#pragma unroll
                        for (int i = 0; i < 4; ++i) { const float z = acc[ai][bj][m][n][i] * rstd; h[4 * n + i] = act ? gelu_tanh(z) : z; }
                    u32x4 o; o[0] = pk2(h[0], h[1]); o[1] = pk2(h[2], h[3]); o[2] = pk2(h[4], h[5]); o[3] = pk2(h[6], h[7]);
                    *(u32x4*)(dst + (size_t)row * 1024 + col0 + bj * 128) = o;
                }
            }
    }
};

template <class Epi>
__device__ __forceinline__ void run_gemm(unsigned char* shm, const bf16_t* A, const bf16_t* Bt, int N, int K, const Epi& E) {
    pg8::Gemm g{A, Bt, T_TOK, N, K};
    pg8::StaticOrder S; S.init(T_TOK, N, GRID, l_bid());
    pg8::gemm_phase<Epi, pg8::StaticOrder, GEMM_ALIGN, GEMM_SP2>((PG8_LAS unsigned char*)shm, g, S, E);
}

template <class Epi>
__device__ __forceinline__ void run_gemm_rs(unsigned char* shm, const bf16_t* A, const bf16_t* Bt, int N, int K, Epi& E, const float* ssq_part) {
    pg8::Gemm g{A, Bt, T_TOK, N, K};
    pg8::StaticOrder S; S.init(T_TOK, N, GRID, l_bid());
    pg8::Unit u0; if (!S.next(0, u0)) return;
    PG8_LAS float* rl = (PG8_LAS float*)(PG8_LAS unsigned char*)shm + 131072 / 4;
    const int tid = l_tid();
    for (int i = tid; i < 1024; i += 512) { const int pm = u0.pm + 8 * (i >> 8);
        if (pm < T_TOK / 256) rl[i] = rsqrtf(row_ssq(ssq_part, pm * 256 + (i & 255)) * (1.f / DM) + EPSN); }
    __syncthreads();
    E.rs = rl; E.pm0 = u0.pm;
    pg8::gemm_phase<Epi, pg8::StaticOrder, false, GEMM_SP2>((PG8_LAS unsigned char*)shm, g, S, E);
}

__device__ __forceinline__ void transpose_item(const float* W, int K, int N, bf16_t* WT, const float* gain, int mode, float* scr, int item, int lane) {
    const int nblk = N / 64, kb = item / nblk, nb = item % nblk, k0 = 64 * kb, n0 = 64 * nb;
    const int r = lane >> 4, c4 = lane & 15;
#pragma unroll 8
    for (int i = 0; i < 16; ++i) { const int kk = 4 * i + r; f32x4 v = *(const f32x4*)(W + (size_t)(k0 + kk) * N + n0 + 4 * c4);
        if (gain) v = v * gain[k0 + kk];
        float* d = scr + kk * 65 + 4 * c4; d[0] = v[0]; d[1] = v[1]; d[2] = v[2]; d[3] = v[3]; }
    asm volatile("s_waitcnt lgkmcnt(0)" ::: "memory");
    const int c = lane & 7, nl = lane >> 3;
#pragma unroll
    for (int j = 0; j < 8; ++j) { const int n = nl + 8 * j; const float* q = scr + (8 * c) * 65 + n;
        u32x4 o; o[0] = pk2(q[0 * 65], q[1 * 65]); o[1] = pk2(q[2 * 65], q[3 * 65]); o[2] = pk2(q[4 * 65], q[5 * 65]); o[3] = pk2(q[6 * 65], q[7 * 65]);
        const int nn = n0 + n; const int row = mode == 0 ? nn : ((nn >> 7) * 256 + (mode == 2 ? 128 : 0) + (nn & 127));
        *(u32x4*)(WT + (size_t)row * K + k0 + 8 * c) = o; }
    asm volatile("s_waitcnt lgkmcnt(0)" ::: "memory");
}

__device__ __forceinline__ void phase_prologue(const Params& p, unsigned char* shm) {
    const int tid = l_tid(), lane = tid & 63, w = tid >> 6;
    const int gw = l_bid() * 8 + w, NGW = GRID * 8;
    float* scr = (float*)(shm + w * 16640);
    constexpr int I_G = (DM / 64) * (FF / 64), I_D = (FF / 64) * (DM / 64), I_IN = (DM / 64) * (2048 / 64), I_OUT = (DM / 64) * (DM / 64);
    constexpr int PER_L = 4 * I_G + 2 * I_D + I_IN + I_OUT;
    for (int it = gw; it < 2 * PER_L; it += NGW) {
        const int l = it / PER_L; int r = it % PER_L;
        unsigned char* wl = p.ws + WS_W + (size_t)l * LW_END;
        const size_t offF = (size_t)l * DM * FF, offN = (size_t)l * DM;
        if (r < I_G) { transpose_item(p.in[2] + offF, DM, FF, (bf16_t*)(wl + LW_GU1), p.in[1] + offN, 1, scr, r, lane); continue; } r -= I_G;
        if (r < I_G) { transpose_item(p.in[3] + offF, DM, FF, (bf16_t*)(wl + LW_GU1), p.in[1] + offN, 2, scr, r, lane); continue; } r -= I_G;
        if (r < I_D) { transpose_item(p.in[4] + offF, FF, DM, (bf16_t*)(wl + LW_D1), nullptr, 0, scr, r, lane); continue; } r -= I_D;
        if (r < I_IN) { transpose_item(p.in[6] + (size_t)l * DM * 2048, DM, 2048, (bf16_t*)(wl + LW_IN), p.in[5] + offN, 0, scr, r, lane); continue; } r -= I_IN;
        if (r < I_OUT) { transpose_item(p.in[21] + (size_t)l * DM * DM, DM, DM, (bf16_t*)(wl + LW_OUT), nullptr, 0, scr, r, lane); continue; } r -= I_OUT;
        if (r < I_G) { transpose_item(p.in[23] + offF, DM, FF, (bf16_t*)(wl + LW_GU2), p.in[22] + offN, 1, scr, r, lane); continue; } r -= I_G;
        if (r < I_G) { transpose_item(p.in[24] + offF, DM, FF, (bf16_t*)(wl + LW_GU2), p.in[22] + offN, 2, scr, r, lane); continue; } r -= I_G;
        transpose_item(p.in[25] + offF, FF, DM, (bf16_t*)(wl + LW_D2), nullptr, 0, scr, r, lane);
    }
    {
        const float* x = p.in[0]; bf16_t* XB = (bf16_t*)(p.ws + WS_XB); float* ssq0 = (float*)(p.ws + WS_SSQ);
        for (int row = gw; row < T_TOK; row += NGW) {
            const f32x4* xr = (const f32x4*)(x + (size_t)row * DM) + lane;
            u32x2* o = (u32x2*)(XB + (size_t)row * DM) + lane;
            float s = 0.f;
#pragma unroll
            for (int j = 0; j < 4; ++j) { const f32x4 v = xr[64 * j]; s += v[0] * v[0] + v[1] * v[1] + v[2] * v[2] + v[3] * v[3];
                u32x2 q; q[0] = pk2(v[0], v[1]); q[1] = pk2(v[2], v[3]); o[64 * j] = q; }
            s = wave_sum(s);
            if (lane < 16) ssq0[(size_t)row * 16 + lane] = lane == 0 ? s : 0.f;
        }
    }
    const int gt = l_bid() * 512 + tid, NT = GRID * 512;
    for (int i = gt; i < 2 * 4 * 128 * 128 / 4; i += NT) {
        const int l = i / (4 * 128 * 128 / 4), r = i % (4 * 128 * 128 / 4);
        const f32x4 v = ((const f32x4*)p.in[8])[i]; u32x2 q; q[0] = pk2(v[0], v[1]); q[1] = pk2(v[2], v[3]);
        ((u32x2*)(p.ws + WS_W + (size_t)l * LW_END + LW_SGU))[r] = q;
    }
    for (int i = gt; i < 2 * 16 * 1536; i += NT) {
        const int l = i / (16 * 1536), r = i % (16 * 1536), n = r / 1536, k = r % 1536;
        const float v = n < 8 ? p.in[15][((size_t)l * 1536 + k) * 8 + n] : p.in[17][((size_t)l * 1536 + k) * 8 + (n - 8)];
        ((bf16_t*)(p.ws + WS_W + (size_t)l * LW_END + LW_GT))[r] = (bf16_t)(pk2(v, 0.f) & 0xffffu);
    }
}

__device__ __forceinline__ void phase_prep(const Params& p, int l, unsigned char* shm) {
    const int tid = l_tid(), lane = tid & 63, w = tid >> 6, fr = lane & 15, fq = lane >> 4;
    const bf16_t* ZXO = (const bf16_t*)(p.ws + WS_ZXO);
    bf16_t* Qb = (bf16_t*)(p.ws + WS_Q); bf16_t* Kb = (bf16_t*)(p.ws + WS_K); bf16_t* Vb = (bf16_t*)(p.ws + WS_V); bf16_t* XCb = (bf16_t*)(p.ws + WS_XC);
    const float* conv_w = p.in[10] + (size_t)l * 5 * 512; const float* conv_b = p.in[11] + (size_t)l * 512;
    const float* wq = p.in[12] + (size_t)l * 128 * 16; const float* wk = p.in[13] + (size_t)l * 128 * 16; const float* wv = p.in[14] + (size_t)l * 128 * 16;
    const bf16_t* WgT = (const bf16_t*)(p.ws + WS_W + (size_t)l * LW_END + LW_GT);
    const float* gbf = p.in[16] + l * 8; const float* gbb = p.in[18] + l * 8;
    float* bvec = (float*)(p.ws + WS_BV); float* avec = (float*)(p.ws + WS_AV); float* cmvec = (float*)(p.ws + WS_CM); float* scal = (float*)(p.ws + WS_SC);
    constexpr int TP = 784;
    unsigned char* tile = shm; float* Gs = (float*)(shm + 128 * TP); unsigned char* wgl = shm + 128 * TP + 8192;
    for (int u = l_bid(); u < 256; u += GRID) {
        const int c = u & 63; const size_t T0 = (size_t)u * 128;
        f32x4 gacc = {0.f, 0.f, 0.f, 0.f};
        for (int hh = 0; hh < 4; ++hh) {
            const int g = tid & 31, tq = tid >> 5, ch = hh * 128 + 4 * g;
            f32x4 cw[5];
#pragma unroll
            for (int j = 0; j < 5; ++j) cw[j] = *(const f32x4*)(conv_w + j * 512 + ch);
            const f32x4 cb = *(const f32x4*)(conv_b + ch);
            f32x4 wq4[4], wk4[4], wv4[4];
#pragma unroll
            for (int i = 0; i < 4; ++i) { const size_t o = (size_t)(hh * 32 + g) * 16 + i * 4; wq4[i] = *(const f32x4*)(wq + o); wk4[i] = *(const f32x4*)(wk + o); wv4[i] = *(const f32x4*)(wv + o); }
            u32x4 wsl[2];
#pragma unroll
            for (int q = 0; q < 2; ++q) { const int ii = tid + 512 * q; if (ii < 768) { const int n = ii / 48, rem = ii % 48, part = rem >> 4, c16 = rem & 15;
                wsl[q] = *(const u32x4*)(WgT + (size_t)n * 1536 + part * 512 + hh * 128 + c16 * 8); } }
#pragma unroll
            for (int i = 0; i < 8; ++i) {
                const int t = tq + 16 * i;
                f32x4 xs[5];
#pragma unroll
                for (int j = 0; j < 5; ++j) {
                    const int pos = c * 128 + t + j - 2;
                    if (pos >= 0 && pos < SEQ) { const u32x2 r = *(const u32x2*)(ZXO + (T0 + t + j - 2) * 1024 + ch);
                        xs[j] = (f32x4){bflo(r[0]), bfhi(r[0]), bflo(r[1]), bfhi(r[1])}; }
                    else xs[j] = (f32x4){0.f, 0.f, 0.f, 0.f};
                }
                f32x4 a = cb;
#pragma unroll
                for (int j = 0; j < 5; ++j) a += cw[j] * xs[j];
                f32x4 xc;
#pragma unroll
                for (int e = 0; e < 4; ++e) xc[e] = a[e] * __builtin_amdgcn_rcpf(1.f + __expf(-a[e]));
                f32x4 q = xc[0] * wq4[0] + xc[1] * wq4[1] + xc[2] * wq4[2] + xc[3] * wq4[3];
                f32x4 k = (xc[0] * wk4[0] + xc[1] * wk4[1] + xc[2] * wk4[2] + xc[3] * wk4[3]) * 0.08838834764831845f;
                f32x4 v = xs[2][0] * wv4[0] + xs[2][1] * wv4[1] + xs[2][2] * wv4[2] + xs[2][3] * wv4[3];
                u32x2 qp, kp, vp, xp;
                qp[0] = pk2(q[0], q[1]); qp[1] = pk2(q[2], q[3]); kp[0] = pk2(k[0], k[1]); kp[1] = pk2(k[2], k[3]);
                vp[0] = pk2(v[0], v[1]); vp[1] = pk2(v[2], v[3]); xp[0] = pk2(xc[0], xc[1]); xp[1] = pk2(xc[2], xc[3]);
                const size_t go = (T0 + t) * 512 + ch;
                *(u32x2*)(Qb + go) = qp; *(u32x2*)(Kb + go) = kp; *(u32x2*)(Vb + go) = vp; *(u32x2*)(XCb + go) = xp;
                unsigned char* tr = tile + t * TP + g * 8;
                *(u32x2*)(tr) = qp; *(u32x2*)(tr + 256) = kp; *(u32x2*)(tr + 512) = vp;
            }
#pragma unroll
            for (int q = 0; q < 2; ++q) { const int ii = tid + 512 * q; if (ii < 768) { const int n = ii / 48, rem = ii % 48, part = rem >> 4, c16 = rem & 15;
                *(u32x4*)(wgl + n * TP + part * 256 + c16 * 16) = wsl[q]; } }
            __syncthreads();
#pragma unroll
            for (int kk = 0; kk < 12; ++kk) {
                const bf16x8 a = *(const bf16x8*)(tile + (16 * w + fr) * TP + kk * 64 + fq * 16);
                const bf16x8 b = *(const bf16x8*)(wgl + fr * TP + kk * 64 + fq * 16);
                gacc = __builtin_amdgcn_mfma_f32_16x16x32_bf16(b, a, gacc, 0, 0, 0);
            }
            __syncthreads();
        }
        { const f32x4 bias = (fq < 2) ? *(const f32x4*)(gbf + fq * 4) : *(const f32x4*)(gbb + (fq - 2) * 4);
          *(f32x4*)(Gs + (16 * w + fr) * 16 + fq * 4) = gacc + bias; }
        __syncthreads();
        {
            const int dir = w >> 2, hs = w & 3;
            const int e0 = 2 * lane, e1 = e0 + 1, p0 = dir ? 127 - e0 : e0, p1 = dir ? 127 - e1 : e1;
            const float ig0 = Gs[p0 * 16 + dir * 8 + hs], ig1 = Gs[p1 * 16 + dir * 8 + hs];
            const float lf0 = logsig(Gs[p0 * 16 + dir * 8 + 4 + hs]), lf1 = logsig(Gs[p1 * 16 + dir * 8 + 4 + hs]);
            const float s1 = lf0 + lf1; float incl = s1;
#pragma unroll
            for (int off = 1; off < 64; off <<= 1) { const float t = __shfl_up(incl, off); if (lane >= off) incl += t; }
            const float excl = incl - s1, b0 = excl + lf0, b1 = excl + s1, btot = __shfl(incl, 63);
            const float a0 = ig0 - b0, a1 = ig1 - b1, c1 = fmaxf(a0, a1); float mx = c1;
#pragma unroll
            for (int off = 1; off < 64; off <<= 1) { const float t = __shfl_up(mx, off); if (lane >= off) mx = fmaxf(mx, t); }
            float ex = __shfl_up(mx, 1); if (lane == 0) ex = -INFINITY;
            const float cm0 = fmaxf(ex, a0), cm1 = fmaxf(ex, c1), amax = __shfl(mx, 63);
            const size_t idx = ((size_t)(u * 4 + hs)) * 2 + dir;
            bvec[idx * 128 + p0] = b0; bvec[idx * 128 + p1] = b1; avec[idx * 128 + p0] = a0; avec[idx * 128 + p1] = a1;
            cmvec[idx * 128 + p0] = cm0; cmvec[idx * 128 + p1] = cm1;
            if (lane == 0) { scal[idx * 2] = btot; scal[idx * 2 + 1] = amax; }
        }
        __syncthreads();
    }
}

__device__ __forceinline__ void load_tile_T(unsigned char* dst, const bf16_t* src, size_t gp, int tid) {
    const int sp = tid & 63, cg0 = tid >> 6;
#pragma unroll
    for (int it = 0; it < 2; ++it) {
        const int chunk = cg0 + 8 * it;
        const bf16_t* sp0 = src + (size_t)(2 * sp) * gp + chunk * 8;
        const u32x4 r0 = *(const u32x4*)sp0, r1 = *(const u32x4*)(sp0 + gp);
#pragma unroll
        for (int e = 0; e < 8; ++e) {
            const unsigned w0 = r0[e >> 1], w1 = r1[e >> 1];
            const unsigned lo = (e & 1) ? (w0 >> 16) : (w0 & 0xffffu), hi = (e & 1) ? (w1 & 0xffff0000u) : (w1 << 16);
            *(unsigned*)(dst + (chunk * 8 + e) * MP + sp * 4) = lo | hi;
        }
    }
}

struct StPre { u32x4 k[2][2], v[2][2]; float a; };
__device__ __forceinline__ void state_issue(StPre& r, const Params& p, int unit, int tid) {
    const int u = unit >> 2, hh = unit & 3; const size_t T0 = (size_t)u * 128;
    const bf16_t* Kb = (const bf16_t*)(p.ws + WS_K); const bf16_t* Vb = (const bf16_t*)(p.ws + WS_V);
    const float* avec = (const float*)(p.ws + WS_AV); const float* scal = (const float*)(p.ws + WS_SC);
    const int sp = tid & 63, cg0 = tid >> 6;
#pragma unroll
    for (int it = 0; it < 2; ++it) { const size_t o = (T0 + 2 * sp) * 512 + hh * 128 + (cg0 + 8 * it) * 8;
        r.k[it][0] = *(const u32x4*)(Kb + o); r.k[it][1] = *(const u32x4*)(Kb + o + 512);
        r.v[it][0] = *(const u32x4*)(Vb + o); r.v[it][1] = *(const u32x4*)(Vb + o + 512); }
    const int t2 = tid & 255, dir = t2 >> 7, s = t2 & 127; const size_t idx = (size_t)unit * 2 + dir;
    r.a = avec[idx * 128 + s] - scal[idx * 2 + 1];
}
__device__ __forceinline__ void phase_state(const Params& p, unsigned char* shm) {
    const int tid = l_tid(), lane = tid & 63, w = tid >> 6, fr = lane & 15, fq = lane >> 4;
    bf16_t* CS = (bf16_t*)(p.ws + WS_CS); float* DN = (float*)(p.ws + WS_DN);
    unsigned char* VT = shm; unsigned char* KTF = shm + MBUF; unsigned char* KTB = shm + 2 * MBUF; float* wk = (float*)(shm + 4 * MBUF);
    int unit = 4 * l_bid(); const int uend = unit + 4;
    StPre r;
    if (unit < 1024) state_issue(r, p, unit, tid);
    for (; unit < uend && unit < 1024; ++unit) {
        if (tid < 256) wk[tid] = __expf(r.a);
        __syncthreads();
        {
            const int sp = tid & 63, cg0 = tid >> 6;
            const float wf0 = wk[2 * sp], wf1 = wk[2 * sp + 1], wb0 = wk[128 + 2 * sp], wb1 = wk[128 + 2 * sp + 1];
#pragma unroll
            for (int it = 0; it < 2; ++it) {
                const int chunk = cg0 + 8 * it;
#pragma unroll
                for (int e = 0; e < 8; ++e) {
                    const unsigned w0 = r.v[it][0][e >> 1], w1 = r.v[it][1][e >> 1];
                    const unsigned lo = (e & 1) ? (w0 >> 16) : (w0 & 0xffffu), hi = (e & 1) ? (w1 & 0xffff0000u) : (w1 << 16);
                    *(unsigned*)(VT + (chunk * 8 + e) * MP + sp * 4) = lo | hi;
                    const float k0 = bfel(r.k[it][0], e), k1 = bfel(r.k[it][1], e);
                    *(unsigned*)(KTF + (chunk * 8 + e) * MP + sp * 4) = pk2(k0 * wf0, k1 * wf1);
                    *(unsigned*)(KTB + (chunk * 8 + e) * MP + sp * 4) = pk2(k0 * wb0, k1 * wb1);
                }
            }
        }
        __syncthreads();
        if (unit + 1 < uend) state_issue(r, p, unit + 1, tid);
#pragma unroll
        for (int dir = 0; dir < 2; ++dir) {
            f32x4 acc[8]; zero8(acc);
            wave_gemm128(acc, VT + 16 * w * MP, dir ? KTB : KTF, fr, fq);
            bf16_t* dst = CS + ((size_t)unit * 2 + dir) * 16384 + (16 * w + fr) * 128 + 4 * fq;
#pragma unroll
            for (int n = 0; n < 8; ++n) { u32x2 o; o[0] = pk2(acc[n][0], acc[n][1]); o[1] = pk2(acc[n][2], acc[n][3]); *(u32x2*)(dst + n * 16) = o; }
        }
        {
            const int k = tid >> 2, part = tid & 3;
#pragma unroll
            for (int dir = 0; dir < 2; ++dir) {
                const unsigned char* base = (dir ? KTB : KTF) + k * MP + part * 64;
                float sm = 0.f;
#pragma unroll
                for (int i = 0; i < 4; ++i) { const u32x4 q = *(const u32x4*)(base + i * 16);
#pragma unroll
                    for (int e = 0; e < 4; ++e) sm += bflo(q[e]) + bfhi(q[e]); }
                sm += __shfl_xor(sm, 1); sm += __shfl_xor(sm, 2);
                if (part == 0) DN[((size_t)unit * 2 + dir) * 128 + k] = sm;
            }
        }
        __syncthreads();
    }
}

struct SgPre { u32x4 v[2][2]; };
__device__ __forceinline__ void sgu_issue(SgPre& r, const Params& p, int unit, int tid) {
    const int u = unit >> 2, hh = unit & 3; const size_t T0 = (size_t)u * 128;
    const bf16_t* ZUV = (const bf16_t*)(p.ws + WS_ZUV);
    const int sp = tid & 63, cg0 = tid >> 6;
#pragma unroll
    for (int it = 0; it < 2; ++it) { const size_t o = (T0 + 2 * sp) * 1024 + 512 + hh * 128 + (cg0 + 8 * it) * 8;
        r.v[it][0] = *(const u32x4*)(ZUV + o); r.v[it][1] = *(const u32x4*)(ZUV + o + 1024); }
}
__device__ __forceinline__ void phase_sgu(const Params& p, int l, unsigned char* shm) {
    const int tid = l_tid(), lane = tid & 63, w = tid >> 6, fr = lane & 15, fq = lane >> 4;
    bf16_t* ZUV = (bf16_t*)(p.ws + WS_ZUV);
    unsigned char* WS = shm; unsigned char* VHT = shm + MBUF; float* part = (float*)(shm + 4 * MBUF);
    const int G = GRID; int unit = l_bid();
    if (unit >= 1024) return;
    const int hh = unit & 3;
    const bf16_t* Wsb = (const bf16_t*)(p.ws + WS_W + (size_t)l * LW_END + LW_SGU);
    const float* gnb = p.in[7] + (size_t)l * 512; const float* bsb = p.in[9] + (size_t)l * 512;
    SgPre r;
    sgu_issue(r, p, unit, tid);
    int staged = -1;
    for (; unit < 1024; unit += G) {
        const int u = unit >> 2, hu = unit & 3; const size_t T0 = (size_t)u * 128;
        if (staged != hu) { load_tile(WS, Wsb + (size_t)hu * 128 * 128, 128, tid); staged = hu; }
        const int sp = tid & 63, cg0 = tid >> 6;
        {
            float s0 = 0.f, q0 = 0.f, s1 = 0.f, q1 = 0.f;
#pragma unroll
            for (int it = 0; it < 2; ++it)
#pragma unroll
                for (int e = 0; e < 4; ++e) { const float a0 = bflo(r.v[it][0][e]), a1 = bfhi(r.v[it][0][e]), b0 = bflo(r.v[it][1][e]), b1 = bfhi(r.v[it][1][e]);
                    s0 += a0 + a1; q0 += a0 * a0 + a1 * a1; s1 += b0 + b1; q1 += b0 * b0 + b1 * b1; }
            *(f32x4*)(part + (cg0 * 128 + 2 * sp) * 2) = (f32x4){s0, q0, s1, q1};
        }
        __syncthreads();
        {
            float s0 = 0.f, q0 = 0.f, s1 = 0.f, q1 = 0.f;
#pragma unroll
            for (int ww = 0; ww < 8; ++ww) { const f32x4 t = *(const f32x4*)(part + (ww * 128 + 2 * sp) * 2); s0 += t[0]; q0 += t[1]; s1 += t[2]; q1 += t[3]; }
            const float mu0 = s0 * (1.f / 128.f), mu1 = s1 * (1.f / 128.f);
            const float rs0 = rsqrtf(fmaxf(q0 * (1.f / 128.f) - mu0 * mu0, 0.f) + EPSN), rs1 = rsqrtf(fmaxf(q1 * (1.f / 128.f) - mu1 * mu1, 0.f) + EPSN);
            const float* gn = gnb + hu * 128;
#pragma unroll
            for (int it = 0; it < 2; ++it) {
                const int chunk = cg0 + 8 * it;
                const f32x4 g0 = *(const f32x4*)(gn + chunk * 8), g1 = *(const f32x4*)(gn + chunk * 8 + 4);
#pragma unroll
                for (int e = 0; e < 8; ++e) {
                    const float gg = e < 4 ? g0[e & 3] : g1[e & 3];
                    const float a = (bfel(r.v[it][0], e) - mu0) * rs0 * gg, b = (bfel(r.v[it][1], e) - mu1) * rs1 * gg;
                    *(unsigned*)(VHT + (chunk * 8 + e) * MP + sp * 4) = pk2(a, b);
                }
            }
        }
        __syncthreads();
        if (unit + G < 1024) sgu_issue(r, p, unit + G, tid);
        const int pr = 16 * w + fr; const float bias = bsb[hu * 128 + pr];
        bf16_t* up = ZUV + (T0 + pr) * 1024 + hu * 128 + 4 * fq;
        u32x2 uu[8];
#pragma unroll
        for (int n = 0; n < 8; ++n) uu[n] = *(const u32x2*)(up + n * 16);
        f32x4 acc[8]; zero8(acc);
        wave_gemm128(acc, WS + 16 * w * MP, VHT, fr, fq);
        {
#pragma unroll
            for (int n = 0; n < 8; ++n) {
                u32x2 o; o[0] = pk2(bflo(uu[n][0]) * (acc[n][0] + bias), bfhi(uu[n][0]) * (acc[n][1] + bias));
                o[1] = pk2(bflo(uu[n][1]) * (acc[n][2] + bias), bfhi(uu[n][1]) * (acc[n][3] + bias));
                *(u32x2*)(up + n * 16) = o;
            }
        }
        __syncthreads();
    }
}

__device__ __forceinline__ void phase_scan_sgu(const Params& p, int l, unsigned char* shm) {
    static_assert(GRID * 512 == 32 * 4096 && 1024 / GRID == 4, "one scan item per thread, four SGU units per block");
    const int tid = l_tid(), lane = tid & 63, w = tid >> 6, fr = lane & 15, fq = lane >> 4;
    bf16_t* ZUV = (bf16_t*)(p.ws + WS_ZUV);
    unsigned char* WS = shm; unsigned char* VHT = shm + MBUF; float* part = (float*)(shm + 4 * MBUF);
    const int G = GRID; int unit = l_bid();
    if (unit >= 1024) return;
    const int hh = unit & 3;
    const bf16_t* Wsb = (const bf16_t*)(p.ws + WS_W + (size_t)l * LW_END + LW_SGU);
    const float* gnb = p.in[7] + (size_t)l * 512; const float* bsb = p.in[9] + (size_t)l * 512;
    SgPre r;
    sgu_issue(r, p, unit, tid);
    int staged = -1;
    bf16_t* CS = (bf16_t*)(p.ws + WS_CS); float* DN = (float*)(p.ws + WS_DN);
    const float* scal = (const float*)(p.ws + WS_SC); float* mst = (float*)(p.ws + WS_MS);
    const int chain = l_bid() >> 3, q4 = (l_bid() & 7) * 512 + tid, sb = chain >> 3, shh = (chain >> 1) & 3, sdir = chain & 1;
    const bool has_n = q4 < 128;
    float C0 = 0.f, C1 = 0.f, C2 = 0.f, C3 = 0.f, nn = 0.f;
    float* cf1 = (float*)(shm + 2 * MBUF); float* cf2 = cf1 + 64; float* cmp = cf1 + 128;
    if (tid < 64) { const int st = tid, c = sdir ? 63 - st : st; const size_t idx = ((size_t)((sb * 64 + c) * 4 + shh)) * 2 + sdir; cf1[st] = scal[idx * 2]; cf2[st] = scal[idx * 2 + 1]; }
    __syncthreads();
    if (tid == 0) { float sm = 0.f;
#pragma unroll 8
        for (int st = 0; st < 64; ++st) { const float bt = cf1[st], am = cf2[st], mm = fmaxf(sm, am);
            cmp[st] = sm; cf1[st] = __expf(sm - mm); cf2[st] = __expf(am - mm); sm = bt + mm; } }
    __syncthreads();
    int kb = 0;
    for (; unit < 1024; unit += G, ++kb) {
        u32x2 sd[8]; float sdn[8];
#define SCAN_ISSUE(ST0) _Pragma("unroll") for (int jj = 0; jj < 8; ++jj) { const int st = (ST0) + jj, c = sdir ? 63 - st : st; const size_t idx = ((size_t)((sb * 64 + c) * 4 + shh)) * 2 + sdir; \
            sd[jj] = *(const u32x2*)(CS + idx * 16384 + q4 * 4); sdn[jj] = has_n ? DN[idx * 128 + q4] : 0.f; }
#define SCAN_CONSUME(ST0) _Pragma("unroll") for (int jj = 0; jj < 8; ++jj) { const int st = (ST0) + jj, c = sdir ? 63 - st : st; const size_t idx = ((size_t)((sb * 64 + c) * 4 + shh)) * 2 + sdir; \
            u32x2 o; o[0] = pk2(C0, C1); o[1] = pk2(C2, C3); *(u32x2*)(CS + idx * 16384 + q4 * 4) = o; \
            if (has_n) DN[idx * 128 + q4] = nn; \
            if (q4 == 0) mst[idx] = cmp[st]; \
            const float f1 = cf1[st], f2 = cf2[st]; \
            C0 = f1 * C0 + f2 * bflo(sd[jj][0]); C1 = f1 * C1 + f2 * bfhi(sd[jj][0]); C2 = f1 * C2 + f2 * bflo(sd[jj][1]); C3 = f1 * C3 + f2 * bfhi(sd[jj][1]); \
            nn = f1 * nn + f2 * sdn[jj]; }
        SCAN_ISSUE(16 * kb)
        const int u = unit >> 2, hu = unit & 3; const size_t T0 = (size_t)u * 128;
        if (staged != hu) { load_tile(WS, Wsb + (size_t)hu * 128 * 128, 128, tid); staged = hu; }
        const int sp = tid & 63, cg0 = tid >> 6;
        {
            float s0 = 0.f, q0 = 0.f, s1 = 0.f, q1 = 0.f;
#pragma unroll
            for (int it = 0; it < 2; ++it)
#pragma unroll
                for (int e = 0; e < 4; ++e) { const float a0 = bflo(r.v[it][0][e]), a1 = bfhi(r.v[it][0][e]), b0 = bflo(r.v[it][1][e]), b1 = bfhi(r.v[it][1][e]);
                    s0 += a0 + a1; q0 += a0 * a0 + a1 * a1; s1 += b0 + b1; q1 += b0 * b0 + b1 * b1; }
            *(f32x4*)(part + (cg0 * 128 + 2 * sp) * 2) = (f32x4){s0, q0, s1, q1};
        }
        __syncthreads();
        {
            float s0 = 0.f, q0 = 0.f, s1 = 0.f, q1 = 0.f;
#pragma unroll
            for (int ww = 0; ww < 8; ++ww) { const f32x4 t = *(const f32x4*)(part + (ww * 128 + 2 * sp) * 2); s0 += t[0]; q0 += t[1]; s1 += t[2]; q1 += t[3]; }
            const float mu0 = s0 * (1.f / 128.f), mu1 = s1 * (1.f / 128.f);
            const float rs0 = rsqrtf(fmaxf(q0 * (1.f / 128.f) - mu0 * mu0, 0.f) + EPSN), rs1 = rsqrtf(fmaxf(q1 * (1.f / 128.f) - mu1 * mu1, 0.f) + EPSN);
            const float* gn = gnb + hu * 128;
#pragma unroll
            for (int it = 0; it < 2; ++it) {
                const int chunk = cg0 + 8 * it;
                const f32x4 g0 = *(const f32x4*)(gn + chunk * 8), g1 = *(const f32x4*)(gn + chunk * 8 + 4);
#pragma unroll
                for (int e = 0; e < 8; ++e) {
                    const float gg = e < 4 ? g0[e & 3] : g1[e & 3];
                    const float a = (bfel(r.v[it][0], e) - mu0) * rs0 * gg, b = (bfel(r.v[it][1], e) - mu1) * rs1 * gg;
                    *(unsigned*)(VHT + (chunk * 8 + e) * MP + sp * 4) = pk2(a, b);
                }
            }
        }
        __syncthreads();
        SCAN_CONSUME(16 * kb)
        SCAN_ISSUE(16 * kb + 8)
        if (unit + G < 1024) sgu_issue(r, p, unit + G, tid);
        const int pr = 16 * w + fr; const float bias = bsb[hu * 128 + pr];
        bf16_t* up = ZUV + (T0 + pr) * 1024 + hu * 128 + 4 * fq;
        u32x2 uu[8];
#pragma unroll
        for (int n = 0; n < 8; ++n) uu[n] = *(const u32x2*)(up + n * 16);
        f32x4 acc[8]; zero8(acc);
        wave_gemm128(acc, WS + 16 * w * MP, VHT, fr, fq);
        {
#pragma unroll
            for (int n = 0; n < 8; ++n) {
                u32x2 o; o[0] = pk2(bflo(uu[n][0]) * (acc[n][0] + bias), bfhi(uu[n][0]) * (acc[n][1] + bias));
                o[1] = pk2(bflo(uu[n][1]) * (acc[n][2] + bias), bfhi(uu[n][1]) * (acc[n][3] + bias));
                *(u32x2*)(up + n * 16) = o;
            }
        }
        __syncthreads();
        SCAN_CONSUME(16 * kb + 8)
#undef SCAN_ISSUE
#undef SCAN_CONSUME
    }
}

__device__ __forceinline__ void phase_scan(const Params& p) {
    const int gt = l_bid() * 512 + l_tid(), NT = GRID * 512;
    bf16_t* CS = (bf16_t*)(p.ws + WS_CS); float* DN = (float*)(p.ws + WS_DN);
    const float* scal = (const float*)(p.ws + WS_SC); float* mst = (float*)(p.ws + WS_MS);
    for (int item = gt; item < 32 * 4096; item += NT) {
        const int chain = item >> 12, q4 = item & 4095, b = chain >> 3, hh = (chain >> 1) & 3, dir = chain & 1;
        float m = 0.f, C0 = 0.f, C1 = 0.f, C2 = 0.f, C3 = 0.f;
        for (int s0 = 0; s0 < 64; s0 += 8) {
            u32x2 d[8]; float bt[8], am[8];
#pragma unroll
            for (int j = 0; j < 8; ++j) { const int st = s0 + j, c = dir ? 63 - st : st; const size_t idx = ((size_t)((b * 64 + c) * 4 + hh)) * 2 + dir;
                d[j] = *(const u32x2*)(CS + idx * 16384 + q4 * 4); bt[j] = scal[idx * 2]; am[j] = scal[idx * 2 + 1]; }
#pragma unroll
            for (int j = 0; j < 8; ++j) { const int st = s0 + j, c = dir ? 63 - st : st; const size_t idx = ((size_t)((b * 64 + c) * 4 + hh)) * 2 + dir;
                u32x2 o; o[0] = pk2(C0, C1); o[1] = pk2(C2, C3); *(u32x2*)(CS + idx * 16384 + q4 * 4) = o;
                if (q4 == 0) mst[idx] = m;
                const float mm = fmaxf(m, am[j]), f1 = __expf(m - mm), f2 = __expf(am[j] - mm);
                C0 = f1 * C0 + f2 * bflo(d[j][0]); C1 = f1 * C1 + f2 * bfhi(d[j][0]); C2 = f1 * C2 + f2 * bflo(d[j][1]); C3 = f1 * C3 + f2 * bfhi(d[j][1]);
                m = bt[j] + mm; }
        }
    }
    for (int item = gt; item < 32 * 128; item += NT) {
        const int chain = item >> 7, k = item & 127, b = chain >> 3, hh = (chain >> 1) & 3, dir = chain & 1;
        float m = 0.f, n = 0.f;
        for (int s0 = 0; s0 < 64; s0 += 8) {
            float d[8], bt[8], am[8];
#pragma unroll
            for (int j = 0; j < 8; ++j) { const int st = s0 + j, c = dir ? 63 - st : st; const size_t idx = ((size_t)((b * 64 + c) * 4 + hh)) * 2 + dir;
                d[j] = DN[idx * 128 + k]; bt[j] = scal[idx * 2]; am[j] = scal[idx * 2 + 1]; }
#pragma unroll
            for (int j = 0; j < 8; ++j) { const int st = s0 + j, c = dir ? 63 - st : st; const size_t idx = ((size_t)((b * 64 + c) * 4 + hh)) * 2 + dir;
                DN[idx * 128 + k] = n;
                const float mm = fmaxf(m, am[j]), f1 = __expf(m - mm), f2 = __expf(am[j] - mm);
                n = f1 * n + f2 * d[j]; m = bt[j] + mm; }
        }
    }
}

struct QKPre { u32x4 q[4], k[4], cf[4], v[2][2]; float va, vM, vb, vn, m; };
__device__ __forceinline__ void issue_qk(QKPre& r, const Params& p, int unit, int tid) {
    const int u = unit >> 2, hh = unit & 3; const size_t ub = (size_t)u * 128 * 512 + hh * 128;
    const bf16_t* Qb = (const bf16_t*)(p.ws + WS_Q) + ub; const bf16_t* Kb = (const bf16_t*)(p.ws + WS_K) + ub; const bf16_t* Vb = (const bf16_t*)(p.ws + WS_V) + ub;
    const bf16_t* Cf = (const bf16_t*)(p.ws + WS_CS) + (size_t)unit * 2 * 16384;
#pragma unroll
    for (int i = 0; i < 4; ++i) { const int id = tid + 512 * i, row = id >> 4, cc = id & 15;
        r.q[i] = *(const u32x4*)(Qb + row * 512 + cc * 8); r.k[i] = *(const u32x4*)(Kb + row * 512 + cc * 8); r.cf[i] = *(const u32x4*)(Cf + row * 128 + cc * 8); }
    const int sp = tid & 63, cg0 = tid >> 6;
#pragma unroll
    for (int it = 0; it < 2; ++it) { const bf16_t* vp = Vb + (2 * sp) * 512 + (cg0 + 8 * it) * 8; r.v[it][0] = *(const u32x4*)vp; r.v[it][1] = *(const u32x4*)(vp + 512); }
    const int t2 = tid & 255; const int vo = unit * 256 + t2;
    const float m = ((const float*)(p.ws + WS_MS))[unit * 2 + (t2 >> 7)];
    r.va = ((const float*)(p.ws + WS_AV))[vo]; r.vM = fmaxf(m, ((const float*)(p.ws + WS_CM))[vo]); r.vb = ((const float*)(p.ws + WS_BV))[vo]; r.vn = ((const float*)(p.ws + WS_DN))[vo]; r.m = m;
}
__device__ __forceinline__ void unit_out(const Params& p, int l, unsigned char* shm, int unit, QKPre& pre, int next) {
    const int tid = l_tid(), lane = tid & 63, w = tid >> 6, fr = lane & 15, fq = lane >> 4;
    const int u = unit >> 2, hh = unit & 3; const size_t T0 = (size_t)u * 128;
    const bf16_t* Qb = (const bf16_t*)(p.ws + WS_Q); const bf16_t* Kb = (const bf16_t*)(p.ws + WS_K); const bf16_t* Vb = (const bf16_t*)(p.ws + WS_V);
    const bf16_t* XCb = (const bf16_t*)(p.ws + WS_XC); const bf16_t* ZXO = (const bf16_t*)(p.ws + WS_ZXO); bf16_t* ZUV = (bf16_t*)(p.ws + WS_ZUV);
    const bf16_t* CS = (const bf16_t*)(p.ws + WS_CS); const float* DN = (const float*)(p.ws + WS_DN);
    const float* bvec = (const float*)(p.ws + WS_BV); const float* avec = (const float*)(p.ws + WS_AV); const float* cmvec = (const float*)(p.ws + WS_CM);
    const float* mst = (const float*)(p.ws + WS_MS);
    const float* mhn = p.in[19] + (size_t)l * 512; const float* skip = p.in[20] + (size_t)l * 512;
    unsigned char* QS = shm; unsigned char* KS = shm + MBUF; unsigned char* VT = shm + 2 * MBUF; unsigned char* CX = shm + 3 * MBUF;
    float* vec = (float*)(shm + 4 * MBUF);
#pragma unroll
    for (int i = 0; i < 4; ++i) { const int id = tid + 512 * i, row = id >> 4, cc = id & 15; *(u32x4*)(QS + row * MP + cc * 16) = pre.q[i]; *(u32x4*)(KS + row * MP + cc * 16) = pre.k[i]; }
#pragma unroll
    for (int i = 0; i < 4; ++i) { const int id = tid + 512 * i, row = id >> 4, cc = id & 15; *(u32x4*)(CX + row * MP + cc * 16) = pre.cf[i]; }
    {
        const int sp = tid & 63, cg0 = tid >> 6;
#pragma unroll
        for (int it = 0; it < 2; ++it)
#pragma unroll
            for (int e = 0; e < 8; ++e) {
                const unsigned w0 = pre.v[it][0][e >> 1], w1 = pre.v[it][1][e >> 1];
                const unsigned lo = (e & 1) ? (w0 >> 16) : (w0 & 0xffffu), hi = (e & 1) ? (w1 & 0xffff0000u) : (w1 << 16);
                *(unsigned*)(VT + ((cg0 + 8 * it) * 8 + e) * MP + sp * 4) = lo | hi;
            }
    }
    if (tid < 256) { const int dir = tid >> 7, s = tid & 127;
        vec[dir * 128 + s] = pre.va; vec[256 + dir * 128 + s] = pre.vM; vec[512 + dir * 128 + s] = pre.vb; vec[768 + dir * 128 + s] = pre.vn;
        if (s == 0) vec[1280 + dir] = pre.m; }
    __syncthreads();
    {
        const int j = tid >> 2, part = tid & 3;
        const unsigned char* qp = QS + j * MP + part * 64;
        float df = 0.f, db = 0.f;
#pragma unroll
        for (int i = 0; i < 4; ++i) { const u32x4 r = *(const u32x4*)(qp + i * 16);
#pragma unroll
            for (int e = 0; e < 4; ++e) { const int k = part * 32 + i * 8 + 2 * e; const float q0 = bflo(r[e]), q1 = bfhi(r[e]);
                df += q0 * vec[768 + k] + q1 * vec[768 + k + 1]; db += q0 * vec[896 + k] + q1 * vec[896 + k + 1]; } }
        df += __shfl_xor(df, 1); df += __shfl_xor(df, 2); db += __shfl_xor(db, 1); db += __shfl_xor(db, 2);
        if (part == 0) { vec[1024 + j] = df; vec[1152 + j] = db; }
    }
    u32x4 cbr[4];
#pragma unroll
    for (int i = 0; i < 4; ++i) { const int id = tid + 512 * i, row = id >> 4, cc = id & 15; cbr[i] = *(const u32x4*)(CS + ((size_t)unit * 2 + 1) * 16384 + row * 128 + cc * 8); }
    f32x4 S[8]; zero8(S);
    wave_gemm128(S, QS + 16 * w * MP, KS, fr, fq);
    __syncthreads();
    const int j = 16 * w + fr;
    float scf, scb;
    {
        const float Mfj = vec[256 + j], Mbj = vec[384 + j], bfj = vec[512 + j], bbj = vec[640 + j], nqfj = vec[1024 + j], nqbj = vec[1152 + j], mf = vec[1280], mb = vec[1281];
        f32x4 Sb[8]; float rf = 0.f, rb = 0.f;
#pragma unroll
        for (int n = 0; n < 8; ++n) {
            const int s0 = n * 16 + 4 * fq;
            const f32x4 af4 = *(const f32x4*)(vec + s0), ab4 = *(const f32x4*)(vec + 128 + s0);
#pragma unroll
            for (int i = 0; i < 4; ++i) {
                const int s = s0 + i;
                const float wf = (s <= j) ? __expf(af4[i] - Mfj) : 0.f, wb = (s >= j) ? __expf(ab4[i] - Mbj) : 0.f;
                const float sv = S[n][i];
                S[n][i] = sv * wf; Sb[n][i] = sv * wb; rf += sv * wf; rb += sv * wb;
            }
        }
        rf += __shfl_xor(rf, 16); rf += __shfl_xor(rf, 32); rb += __shfl_xor(rb, 16); rb += __shfl_xor(rb, 32);
        const float wif = __expf(mf - Mfj), wib = __expf(mb - Mbj);
        const float nqf = wif * nqfj + rf, nqb = wib * nqbj + rb;
        const float invf = 1.f / fmaxf(fabsf(nqf), __expf(-(bfj + Mfj))), invb = 1.f / fmaxf(fabsf(nqb), __expf(-(bbj + Mbj)));
        scf = wif * invf; scb = wib * invb;
#pragma unroll
        for (int n = 0; n < 8; ++n) {
            const f32x4 P = S[n] * invf + Sb[n] * invb;
            u32x2 o; o[0] = pk2(P[0], P[1]); o[1] = pk2(P[2], P[3]);
            *(u32x2*)(KS + j * MP + (n * 16 + 4 * fq) * 2) = o;
        }
    }
    f32x4 aF[8], aI[8]; zero8(aF); zero8(aI);
    wave_gemm128(aF, QS + 16 * w * MP, CX, fr, fq);
    wave_gemm128(aI, KS + 16 * w * MP, VT, fr, fq);
    __syncthreads();
#pragma unroll
    for (int i = 0; i < 4; ++i) { const int id = tid + 512 * i, row = id >> 4, cc = id & 15; *(u32x4*)(CX + row * MP + cc * 16) = cbr[i]; }
    u32x2 xcr[8], ogr[8];
#pragma unroll
    for (int n = 0; n < 8; ++n) { const int ch = hh * 128 + n * 16 + 4 * fq;
        xcr[n] = *(const u32x2*)(XCb + (T0 + j) * 512 + ch); ogr[n] = *(const u32x2*)(ZXO + (T0 + j) * 1024 + 512 + ch); }
    if (next >= 0) issue_qk(pre, p, next, tid);
    __syncthreads();
    f32x4 aB[8]; zero8(aB);
    wave_gemm128(aB, QS + 16 * w * MP, CX, fr, fq);
    float sum = 0.f;
#pragma unroll
    for (int n = 0; n < 8; ++n) { aI[n] = aI[n] + aF[n] * scf + aB[n] * scb; sum += aI[n][0] + aI[n][1] + aI[n][2] + aI[n][3]; }
    sum += __shfl_xor(sum, 16); sum += __shfl_xor(sum, 32);
    const float mu = sum * (1.f / 128.f);
    float s2 = 0.f;
#pragma unroll
    for (int n = 0; n < 8; ++n) { const f32x4 d = aI[n] - mu; s2 += d[0] * d[0] + d[1] * d[1] + d[2] * d[2] + d[3] * d[3]; }
    s2 += __shfl_xor(s2, 16); s2 += __shfl_xor(s2, 32);
    const float rs = rsqrtf(s2 * (1.f / 128.f) + EPSN);
#pragma unroll
    for (int n = 0; n < 8; ++n) {
        const int ch = hh * 128 + n * 16 + 4 * fq;
        const f32x4 gn = *(const f32x4*)(mhn + ch), sk = *(const f32x4*)(skip + ch);
        const u32x2 xr = xcr[n], orr = ogr[n];
        const f32x4 xc = {bflo(xr[0]), bfhi(xr[0]), bflo(xr[1]), bfhi(xr[1])}, og = {bflo(orr[0]), bfhi(orr[0]), bflo(orr[1]), bfhi(orr[1])};
        f32x4 y;
#pragma unroll
        for (int i = 0; i < 4; ++i) y[i] = ((aI[n][i] - mu) * rs * gn[i] + sk[i] * xc[i]) * sigmoidf_(og[i]);
        u32x2 o; o[0] = pk2(y[0], y[1]); o[1] = pk2(y[2], y[3]);
        *(u32x2*)(ZUV + (T0 + j) * 1024 + 512 + ch) = o;
    }
    __syncthreads();
}

__device__ __forceinline__ void phase_final(const Params& p) {
    const int tid = l_tid(), lane = tid & 63, w = tid >> 6;
    const int gw = l_bid() * 8 + w, NGW = GRID * 8;
    const float* ssq = (const float*)(p.ws + WS_SSQ) + (size_t)6 * T_TOK * 16; const float* g = p.in[26];
    const bf16_t* XB = (const bf16_t*)(p.ws + WS_XB);
    f32x4 gg[4];
#pragma unroll
    for (int j = 0; j < 4; ++j) gg[j] = ((const f32x4*)g)[lane + 64 * j];
    for (int row = gw; row < T_TOK; row += NGW) {
        float s = lane < 16 ? ssq[(size_t)row * 16 + lane] : 0.f;
        s += __shfl_xor(s, 1); s += __shfl_xor(s, 2); s += __shfl_xor(s, 4); s += __shfl_xor(s, 8);
        s = __shfl(s, 0);
        const float rstd = rsqrtf(s * (1.f / DM) + EPSN);
        const u32x2* xb = (const u32x2*)(XB + (size_t)row * DM) + lane;
        f32x4* o = (f32x4*)(p.out + (size_t)row * DM) + lane;
#pragma unroll
        for (int j = 0; j < 4; ++j) { const u32x2 t = xb[64 * j]; o[64 * j] = (f32x4){bflo(t[0]), bfhi(t[0]), bflo(t[1]), bfhi(t[1])} * rstd * gg[j]; }
    }
}

__global__ __launch_bounds__(512, 2) void mega_fwd(Params p) {
    extern __shared__ __attribute__((aligned(16))) unsigned char shm[];
    cg::grid_group grid = cg::this_grid();
    float* ssq = (float*)(p.ws + WS_SSQ);
    bf16_t* XB = (bf16_t*)(p.ws + WS_XB); bf16_t* Hh = (bf16_t*)(p.ws + WS_U);
    bf16_t* ZUV = (bf16_t*)(p.ws + WS_ZUV); bf16_t* ZXO = (bf16_t*)(p.ws + WS_ZXO);
    volatile LAS unsigned* st = (volatile LAS unsigned*)((PG8_LAS unsigned char*)shm + LDS_MAIN);
    if (threadIdx.x == 0) { st[0] = 0u; st[1] = 0u; st[2] = 0u; st[3] = 0u; }
    __syncthreads();
    XcdBarrier xbar = xcd_barrier_post((unsigned*)(p.ws + WS_BAR), st);
    for (int ph = p.ph_lo; ph < p.ph_hi; ++ph) {
        if (ph >= 1 && ph <= 20 && (ph - 1) % 10 == 4) continue;
        if (ph > p.ph_lo) { if (p.ph_hi > 1000) grid.sync(); else xcd_barrier(xbar); }
        if (ph == 0) { phase_prologue(p, shm); continue; }
        if (ph == 21) { phase_final(p); continue; }
        const int l = (ph - 1) / 10, s = (ph - 1) % 10;
        const unsigned char* wl = p.ws + WS_W + (size_t)l * LW_END;
        const float* ss_a = ssq + (size_t)(3 * l) * T_TOK * 16;
        float* ss_b = ssq + (size_t)(3 * l + 1) * T_TOK * 16;
        float* ss_c = ssq + (size_t)(3 * l + 2) * T_TOK * 16;
        float* ss_d = ssq + (size_t)(3 * l + 3) * T_TOK * 16;
        switch (s) {
        case 0: { EpiUp E{Hh, nullptr, 0}; run_gemm_rs(shm, XB, (const bf16_t*)(wl + LW_GU1), 2 * FF, DM, E, ss_a); } break;
        case 1: { EpiRes<false> E{nullptr, XB, ss_b, 0.5f}; run_gemm(shm, Hh, (const bf16_t*)(wl + LW_D1), DM, FF, E); } break;
        case 2: { EpiWin E{ZUV, ZXO, nullptr, 0}; run_gemm_rs(shm, XB, (const bf16_t*)(wl + LW_IN), 2048, DM, E, ss_b); } break;
        case 3: phase_prep(p, l, shm); asm volatile("s_waitcnt vmcnt(0)" ::: "memory"); __syncthreads(); phase_state(p, shm); break;
        case 4: break;
        case 5: phase_scan_sgu(p, l, shm); break;
        case 6: { QKPre pre; int k = l_bid(); issue_qk(pre, p, k, l_tid());
                  for (; k < 1024; k += GRID) unit_out(p, l, shm, k, pre, k + GRID < 1024 ? k + GRID : -1); } break;
        case 7: { EpiRes<false> E{nullptr, XB, ss_c, 1.0f}; run_gemm(shm, ZUV, (const bf16_t*)(wl + LW_OUT), DM, DM, E); } break;
        case 8: { EpiUp E{Hh, nullptr, 0}; run_gemm_rs(shm, XB, (const bf16_t*)(wl + LW_GU2), 2 * FF, DM, E, ss_c); } break;
        case 9: { EpiRes<false> E{nullptr, XB, ss_d, 0.5f}; run_gemm(shm, Hh, (const bf16_t*)(wl + LW_D2), DM, FF, E); } break;
        }
    }
}

#ifndef ONE_LAUNCH
#define ONE_LAUNCH 1
#endif
extern "C" void kernel_launch(void* const* d_in, const int* in_sizes, int n_in, void* d_out, int out_size, void* d_ws, size_t ws_size, hipStream_t stream) {
    static int grid = 0;
    if (grid == 0) {
        if (n_in != 27 || ws_size < WS_END) { fprintf(stderr, "kernel_launch: unexpected n_in %d or ws_size %zu (need %zu)\n", n_in, ws_size, (size_t)WS_END); grid = -1; return; }
        int dev = 0, cus = 0, per_cu = 0;
        hipGetDevice(&dev);
        hipDeviceGetAttribute(&cus, hipDeviceAttributeMultiprocessorCount, dev);
        if (hipFuncSetAttribute((const void*)mega_fwd, hipFuncAttributeMaxDynamicSharedMemorySize, LDS_BYTES) != hipSuccess) { fprintf(stderr, "kernel_launch: hipFuncSetAttribute failed\n"); grid = -1; return; }
        if (hipOccupancyMaxActiveBlocksPerMultiprocessor(&per_cu, (const void*)mega_fwd, 512, LDS_BYTES) != hipSuccess || per_cu < 1) { fprintf(stderr, "kernel_launch: occupancy query says %d\n", per_cu); per_cu = 1; }
        (void)hipGetLastError();
        grid = cus * per_cu;
        if (grid < GRID) { fprintf(stderr, "kernel_launch: this build needs %d co-resident workgroups, device offers %d\n", GRID, grid); grid = -1; return; }
        grid = GRID;
    }
    if (grid < 0) return;
    (void)hipMemsetAsync((unsigned char*)d_ws + WS_BAR, 0, (size_t)XCD_BAR_WORDS * 4, stream);
    Params p{};
    for (int i = 0; i < 27; ++i) p.in[i] = (const float*)d_in[i];
    p.out = (float*)d_out; p.ws = (unsigned char*)d_ws;
#if ONE_LAUNCH
    p.ph_lo = 0; p.ph_hi = 22;
    void* args[] = {&p};
    hipError_t e = hipLaunchCooperativeKernel((const void*)mega_fwd, dim3(grid), dim3(512), args, LDS_BYTES, stream);
    if (e != hipSuccess) fprintf(stderr, "cooperative launch failed: %s (grid %d)\n", hipGetErrorString(e), grid);
#else
    for (int ph = 0; ph < 22; ++ph) { p.ph_lo = ph; p.ph_hi = ph + 1; hipLaunchKernelGGL(mega_fwd, dim3(grid), dim3(512), LDS_BYTES, stream, p); }
#endif
}
```

```cpp
#include <hip/hip_runtime.h>
#include <hip/hip_cooperative_groups.h>
#include <cstdio>
namespace cg = cooperative_groups;
#ifndef GEMM_SP2
#define GEMM_SP2 true
#endif
#ifndef GEMM_ALIGN
#define GEMM_ALIGN true
#endif
constexpr int GRID = 256;

typedef unsigned short bf16_t;
typedef short bf16x8 __attribute__((ext_vector_type(8)));
typedef float f32x4 __attribute__((ext_vector_type(4)));
typedef unsigned u32x4 __attribute__((ext_vector_type(4)));
typedef unsigned u32x2 __attribute__((ext_vector_type(2)));

__device__ __forceinline__ int l_tid() { int t = threadIdx.x; asm volatile("" : "+v"(t)); return t; }
__device__ __forceinline__ int l_bid() { int t = blockIdx.x; asm volatile("" : "+s"(t)); return t; }

namespace pg8 {
#define PG8_LAS __attribute__((address_space(3)))
constexpr int BM = 256, BK = 64, HALF = 128, HTB = HALF * BK * 2  , STAGE_BYTES = 8 * HTB, NXCD = 8, WGM = 8;

__host__ __device__ __forceinline__ int lds_byte(int r, int c) { const int st = (r >> 4) * 2 + (c >> 5), rr = r & 15, cc = c & 31, ob = rr * 64 + cc * 2; return st * 1024 + (ob ^ (((ob >> 9) & 1) << 5)); }
__host__ __device__ __forceinline__ void stage_rc(int b, int& R, int& C) { const int st = b / 1024, sb = b % 1024, swz = sb ^ (((sb >> 9) & 1) << 5); R = (st >> 1) * 16 + swz / 64; C = (st & 1) * 32 + (swz % 64) / 2; }
__host__ __device__ __forceinline__ int perm32(int rho) { const int n = rho >> 4, i = rho & 15; return 8 * (i >> 2) + 4 * n + (i & 3); }

struct Unit { int pm, pn; };
struct Gemm { const bf16_t* A; const bf16_t* Bt; int M, N, K; };

struct StaticOrder {
    int nM, nN, nwg, G, c;
    __host__ __device__ void init(int M, int N, int G_, int c_) { nM = M / BM; nN = N / BM; nwg = nM * nN; G = G_; c = c_; }
    __host__ __device__ bool next(int i, Unit& u) const {
        const long L = (long)i * G + c; if (L >= nwg) return false;
        int wgid = (int)L; { const int q = nwg / NXCD, r = nwg % NXCD, xcd = wgid % NXCD, off = wgid / NXCD; wgid = (xcd < r ? xcd * (q + 1) : r * (q + 1) + (xcd - r) * q) + off; }
        const int nig = WGM * nN, gid = wgid / nig, fm = gid * WGM, gsz = (nM - fm) < WGM ? (nM - fm) : WGM;
        u.pm = fm + ((wgid % nig) % gsz); u.pn = (wgid % nig) / gsz; return true;
    }
    __device__ __forceinline__ void a_ready(const Unit&) const {}
    __device__ __forceinline__ void done(const Unit&) const {}
};

template <class Epi, class Sched, bool ALIGN_EPI = false, bool SP2 = false>
__device__ __forceinline__ void gemm_phase(PG8_LAS unsigned char* lds, const Gemm g, const Sched& S, const Epi& E) {
    const int tid = l_tid(), wid = __builtin_amdgcn_readfirstlane(tid >> 6), lane = tid & 63, wr = wid >> 2, wc = wid & 3, fr = lane & 15, fq = lane >> 4;
    const int K = g.K, nt = K / BK;
    unsigned voffA[2], voffB[2];
#pragma unroll
    for (int i = 0; i < 2; ++i) { int R, C; stage_rc(tid * 16 + i * 8192, R, C); const int Rb = Epi::PERM ? ((R & ~31) + perm32(R & 31)) : R;
        voffA[i] = (unsigned)(R * K + C) * 2u; voffB[i] = (unsigned)(Rb * K + C) * 2u; }
    const size_t kstep = (size_t)(BK * 2);
    const size_t hstep = (size_t)HALF * K * 2;
    const size_t tstep = 2 * hstep;
    const unsigned ldsw = (unsigned)wid * 1024u;
    const int aoff = lds_byte(wr * 64 + fr, fq * 8), boff = lds_byte(wc * 32 + fr, fq * 8);
#define PG8_SA(b, h) (((b) * 2 + (h)) * HTB)
#define PG8_SB(b, h) ((4 + (b) * 2 + (h)) * HTB)
#define PG8_STAGE(bufoff, gbase, voff) do { _Pragma("unroll") for (int _i = 0; _i < 2; ++_i) \
        __builtin_amdgcn_global_load_lds((const unsigned*)((const char*)(gbase) + (voff)[_i]), (PG8_LAS unsigned*)(lds + (bufoff) + ldsw + _i * 8192), 16, 0, 0); } while (0)
#define PG8_LDA(dst, b, h) do { _Pragma("unroll") for (int m = 0; m < 4; ++m) _Pragma("unroll") for (int k = 0; k < 2; ++k) dst[m][k] = *(const PG8_LAS bf16x8*)(lds + PG8_SA(b, h) + aoff + m * 2048 + k * 1024); } while (0)
#define PG8_LDB(dst, b, h) do { _Pragma("unroll") for (int n = 0; n < 2; ++n) _Pragma("unroll") for (int k = 0; k < 2; ++k) dst[n][k] = *(const PG8_LAS bf16x8*)(lds + PG8_SB(b, h) + boff + n * 2048 + k * 1024); } while (0)
#define PG8_MMA(ai, bj, At, Bt) do { __builtin_amdgcn_s_setprio(1); _Pragma("unroll") for (int m = 0; m < 4; ++m) _Pragma("unroll") for (int n = 0; n < 2; ++n) _Pragma("unroll") for (int k = 0; k < 2; ++k) \
        acc[ai][bj][m][n] = __builtin_amdgcn_mfma_f32_16x16x32_bf16(Bt[n][k], At[m][k], acc[ai][bj][m][n], 0, 0, 0); __builtin_amdgcn_s_setprio(0); } while (0)
#define PG8_WAIT_V(n) asm volatile("s_waitcnt vmcnt(" #n ")" ::: "memory")
#define PG8_WAIT_L(n) asm volatile("s_waitcnt lgkmcnt(" #n ")" ::: "memory")
#define PG8_BAR __builtin_amdgcn_s_barrier()
#define PG8_SCHED __builtin_amdgcn_sched_barrier(0)
    Unit cur, nxt; int ui = 0;
    if (!S.next(0, cur)) return;
    f32x4 acc[2][2][4][2];
#pragma unroll
    for (int a = 0; a < 2; ++a)
#pragma unroll
        for (int b = 0; b < 2; ++b)
#pragma unroll
            for (int m = 0; m < 4; ++m)
#pragma unroll
                for (int n = 0; n < 2; ++n) acc[a][b][m][n] = (f32x4){0.f, 0.f, 0.f, 0.f};
    bf16x8 At[4][2], B0[2][2], B1[2][2];
    const char* cA = (const char*)g.A + (size_t)cur.pm * tstep; const char* cB = (const char*)g.Bt + (size_t)cur.pn * tstep;
    S.a_ready(cur);
    if constexpr (SP2) {
        PG8_STAGE(PG8_SB(0, 0), cB, voffB); PG8_STAGE(PG8_SB(0, 1), cB + hstep, voffB); PG8_STAGE(PG8_SA(0, 0), cA, voffA); PG8_STAGE(PG8_SA(0, 1), cA + hstep, voffA);
        if (wr == 1) PG8_BAR;
        PG8_WAIT_V(2); PG8_BAR;
        PG8_STAGE(PG8_SB(1, 0), cB + kstep, voffB); PG8_STAGE(PG8_SA(1, 0), cA + kstep, voffA); PG8_STAGE(PG8_SB(1, 1), cB + hstep + kstep, voffB);
        PG8_WAIT_V(6); PG8_BAR;
    } else {
        PG8_STAGE(PG8_SB(0, 0), cB, voffB); PG8_STAGE(PG8_SA(0, 0), cA, voffA); PG8_STAGE(PG8_SB(0, 1), cB + hstep, voffB); PG8_STAGE(PG8_SA(0, 1), cA + hstep, voffA);
        if (wr == 1) PG8_BAR;
        PG8_WAIT_V(4); PG8_BAR;
        PG8_STAGE(PG8_SB(1, 0), cB + kstep, voffB); PG8_STAGE(PG8_SA(1, 0), cA + kstep, voffA); PG8_STAGE(PG8_SB(1, 1), cB + hstep + kstep, voffB);
        PG8_WAIT_V(6); PG8_BAR;
    }
    for (;;) {
        const bool has_next = S.next(ui + 1, nxt);
        const char* nA = has_next ? (const char*)g.A + (size_t)nxt.pm * tstep : cA; const char* nB = has_next ? (const char*)g.Bt + (size_t)nxt.pn * tstep : cB;
        for (int t = 0; t < nt; t += 2) {
            const bool last = (t == nt - 2);
            const char* a1 = cA + (size_t)(t + 1) * kstep;
            const char* a2 = last ? nA : cA + (size_t)(t + 2) * kstep; const char* b2 = last ? nB : cB + (size_t)(t + 2) * kstep;
            const char* a3 = a2 + kstep; const char* b3 = b2 + kstep;
            if (last && has_next) S.a_ready(nxt);
            if constexpr (SP2) {
            PG8_LDB(B0, 0, 0); PG8_LDB(B1, 0, 1); PG8_SCHED; PG8_LDA(At, 0, 0); PG8_STAGE(PG8_SA(1, 1), a1 + hstep, voffA);
            PG8_WAIT_V(8); PG8_WAIT_L(0); PG8_BAR; PG8_MMA(0, 0, At, B0); PG8_MMA(0, 1, At, B1); PG8_BAR; PG8_SCHED;
            PG8_LDA(At, 0, 1); PG8_STAGE(PG8_SB(0, 0), b2, voffB); PG8_STAGE(PG8_SB(0, 1), b2 + hstep, voffB); PG8_STAGE(PG8_SA(0, 0), a2, voffA);
            PG8_WAIT_V(8); PG8_WAIT_L(0); PG8_BAR; PG8_MMA(1, 0, At, B0); PG8_MMA(1, 1, At, B1); PG8_BAR; PG8_SCHED;
            PG8_LDB(B0, 1, 0); PG8_LDB(B1, 1, 1); PG8_SCHED; PG8_LDA(At, 1, 0); PG8_STAGE(PG8_SA(0, 1), a2 + hstep, voffA);
            PG8_WAIT_V(8); PG8_WAIT_L(0); PG8_BAR; PG8_MMA(0, 0, At, B0); PG8_MMA(0, 1, At, B1); PG8_BAR; PG8_SCHED;
            PG8_LDA(At, 1, 1); PG8_STAGE(PG8_SB(1, 0), b3, voffB); PG8_STAGE(PG8_SB(1, 1), b3 + hstep, voffB); PG8_STAGE(PG8_SA(1, 0), a3, voffA);
            PG8_WAIT_V(8); PG8_WAIT_L(0); PG8_BAR; PG8_MMA(1, 0, At, B0); PG8_MMA(1, 1, At, B1); PG8_BAR; PG8_SCHED;
            } else {
            PG8_LDB(B0, 0, 0); PG8_SCHED; PG8_LDA(At, 0, 0); PG8_STAGE(PG8_SA(1, 1), a1 + hstep, voffA);
            PG8_WAIT_L(8); PG8_BAR; PG8_WAIT_L(0); PG8_MMA(0, 0, At, B0); PG8_BAR; PG8_SCHED;
            PG8_LDB(B1, 0, 1); PG8_STAGE(PG8_SB(0, 0), b2, voffB);
            PG8_BAR; PG8_WAIT_L(0); PG8_MMA(0, 1, At, B1); PG8_BAR;
            PG8_LDA(At, 0, 1); PG8_STAGE(PG8_SA(0, 0), a2, voffA);
            PG8_BAR; PG8_WAIT_L(0); PG8_MMA(1, 0, At, B0); PG8_BAR; PG8_SCHED;
            PG8_STAGE(PG8_SB(0, 1), b2 + hstep, voffB);
            PG8_WAIT_V(6); PG8_BAR; PG8_MMA(1, 1, At, B1); PG8_BAR;
            PG8_LDB(B0, 1, 0); PG8_SCHED; PG8_LDA(At, 1, 0); PG8_STAGE(PG8_SA(0, 1), a2 + hstep, voffA);
            PG8_WAIT_L(8); PG8_BAR; PG8_WAIT_L(0); PG8_MMA(0, 0, At, B0); PG8_BAR; PG8_SCHED;
            PG8_LDB(B1, 1, 1); PG8_STAGE(PG8_SB(1, 0), b3, voffB);
            PG8_BAR; PG8_WAIT_L(0); PG8_MMA(0, 1, At, B1); PG8_BAR;
            PG8_LDA(At, 1, 1); PG8_STAGE(PG8_SA(1, 0), a3, voffA);
            PG8_BAR; PG8_WAIT_L(0); PG8_MMA(1, 0, At, B0); PG8_BAR; PG8_SCHED;
            PG8_STAGE(PG8_SB(1, 1), b3 + hstep, voffB);
            PG8_WAIT_V(6); PG8_BAR; PG8_MMA(1, 1, At, B1); PG8_BAR;
            }
        }
        if constexpr (ALIGN_EPI) { if (wr == 0) PG8_BAR; }
        if constexpr (!Epi::AFTER_DRAIN) { E(acc, cur, wr, wc, fr, fq); S.done(cur); }
        if (!has_next) break;
#pragma unroll
        for (int a = 0; a < 2; ++a)
#pragma unroll
            for (int b = 0; b < 2; ++b)
#pragma unroll
                for (int m = 0; m < 4; ++m)
#pragma unroll
                    for (int n = 0; n < 2; ++n) acc[a][b][m][n] = (f32x4){0.f, 0.f, 0.f, 0.f};
        cur = nxt; cA = nA; cB = nB; ++ui;
        if constexpr (ALIGN_EPI) { if (wr == 1) PG8_BAR; }
    }
    PG8_WAIT_V(0);
    if constexpr (!ALIGN_EPI) { if (wr == 0) PG8_BAR; }
    PG8_BAR;
    if constexpr (Epi::AFTER_DRAIN) { E.fused(acc, cur, wr, wc, fr, fq, lds, wid, lane); S.done(cur); }
#undef PG8_SA
#undef PG8_SB
#undef PG8_STAGE
#undef PG8_LDA
#undef PG8_LDB
#undef PG8_MMA
#undef PG8_WAIT_V
#undef PG8_WAIT_L
#undef PG8_BAR
#undef PG8_SCHED
}
}

#define XB_TMO      128
#define XB_XCNT(j)  (256  + 64 * (j))
#define XB_XSUB(j)  (1280 + 64 * (j))
#define XB_XGEN(j)  (2304 + 64 * (j))
#define XB_TOP      3328
#define XB_TOPGEN   3392
#define XCD_BAR_WORDS 3456
#define XB_SPIN_CAP (1u << 18)
#define LAS __attribute__((address_space(3)))

__device__ __forceinline__ unsigned xb_ld(unsigned* p)              { return __hip_atomic_load(p, __ATOMIC_RELAXED, __HIP_MEMORY_SCOPE_AGENT); }
__device__ __forceinline__ unsigned xb_add(unsigned* p, unsigned v) { return __hip_atomic_fetch_add(p, v, __ATOMIC_RELAXED, __HIP_MEMORY_SCOPE_AGENT); }
__device__ __forceinline__ unsigned xb_xcc_id() { return (unsigned)__builtin_amdgcn_s_getreg((3 << 11) | 20) & 0xFu; }
#define XB_SPIN(cond, bar) do { unsigned _sp = 0; while (cond) { __builtin_amdgcn_s_sleep(0); \
    if ((++_sp & 255u) == 0u) { if (xb_ld(&(bar)[XB_TMO])) break; if (_sp > XB_SPIN_CAP) { atomicAdd(&(bar)[XB_TMO], 1u); break; } } } } while (0)

struct XcdBarrier {
    unsigned* bar; unsigned x;
    volatile LAS unsigned* st;
};

__device__ __forceinline__ XcdBarrier xcd_barrier_post(unsigned* bar, volatile LAS unsigned* st) {
    XcdBarrier b; b.bar = bar; b.x = xb_xcc_id(); b.st = st;
    if (threadIdx.x == 0) (void)xb_add(&bar[XB_XCNT(b.x)], 1u);
    return b;
}
__device__ __forceinline__ void xcd_barrier_complete(unsigned* bar, unsigned x, unsigned& nloc, unsigned& nx) {
    const unsigned G = GRID;
    unsigned sum, cnt, mine, sp = 0u;
    for (;;) {
        sum = 0u; cnt = 0u; mine = 0u;
#pragma unroll
        for (unsigned j = 0; j < 16; ++j) { const unsigned c = xb_ld(&bar[XB_XCNT(j)]); sum += c; cnt += (c > 0u) ? 1u : 0u; mine = (j == x) ? c : mine; }
        if (sum == G) break;
        __builtin_amdgcn_s_sleep(1);
        if ((++sp & 255u) == 0u) { if (xb_ld(&bar[XB_TMO])) break; if (sp > XB_SPIN_CAP) { atomicAdd(&bar[XB_TMO], 1u); break; } }
    }
    nloc = mine > 0u ? mine : 1u; nx = cnt > 0u ? cnt : 1u;
}

__device__ __forceinline__ void xcd_barrier(const XcdBarrier& b) {
    asm volatile("s_waitcnt vmcnt(0)" ::: "memory");
    __syncthreads();
    if (threadIdx.x == 0) {
        unsigned* bar = b.bar;
        __builtin_amdgcn_s_waitcnt(0);
        unsigned nloc = b.st[0], nx = b.st[1];
        if (nloc == 0u) { xcd_barrier_complete(bar, b.x, nloc, nx); b.st[0] = nloc; b.st[1] = nx; }
        const unsigned old = xb_add(&bar[XB_XSUB(b.x)], 1u);
        const unsigned gen = old / nloc;
        if (old + 1u == (gen + 1u) * nloc) {
            __builtin_amdgcn_fence(__ATOMIC_RELEASE, "agent");
            asm volatile("s_waitcnt vmcnt(0)" ::: "memory");
            const unsigned og = xb_add(&bar[XB_TOP], 1u);
            const unsigned tg = og / nx;
            if (og + 1u == (tg + 1u) * nx) xb_add(&bar[XB_TOPGEN], 1u);
            else XB_SPIN(xb_ld(&bar[XB_TOPGEN]) == tg, bar);
            __builtin_amdgcn_fence(__ATOMIC_ACQUIRE, "agent");
            xb_add(&bar[XB_XGEN(b.x)], 1u);
            asm volatile("s_waitcnt vmcnt(0)" ::: "memory");
        } else {
            XB_SPIN(xb_ld(&bar[XB_XGEN(b.x)]) == gen, bar);
            __builtin_amdgcn_fence(__ATOMIC_ACQUIRE, "agent");
            asm volatile("s_waitcnt vmcnt(0)" ::: "memory");
        }
    }
    __syncthreads();
}


constexpr int T_TOK = 32768, DM = 1024, FF = 2816, SEQ = 8192, NCH = 64;
constexpr float EPSN = 1e-6f;
constexpr int MP = 272;
constexpr int MBUF = 128 * MP;
constexpr int LDS_MAIN = 4 * MBUF + 8192;
constexpr int LDS_BYTES = LDS_MAIN + 16;

constexpr size_t SZ_WGU = (size_t)2 * FF * DM * 2, SZ_WD = (size_t)DM * FF * 2, SZ_WIN = (size_t)2048 * DM * 2, SZ_WOUT = (size_t)DM * DM * 2;
constexpr size_t SZ_SGUW = (size_t)4 * 128 * 128 * 2, SZ_WGT = (size_t)16 * 1536 * 2;
constexpr size_t LW_GU1 = 0, LW_D1 = LW_GU1 + SZ_WGU, LW_IN = LW_D1 + SZ_WD, LW_OUT = LW_IN + SZ_WIN, LW_GU2 = LW_OUT + SZ_WOUT, LW_D2 = LW_GU2 + SZ_WGU,
                 LW_SGU = LW_D2 + SZ_WD, LW_GT = LW_SGU + SZ_SGUW, LW_END = LW_GT + SZ_WGT;
constexpr size_t WS_W = 0;
constexpr size_t WS_XB = WS_W + 2 * LW_END;
constexpr size_t WS_U = WS_XB + (size_t)T_TOK * DM * 2;
constexpr size_t WS_ZUV = WS_U, WS_ZXO = WS_ZUV + (size_t)T_TOK * 1024 * 2, WS_Q = WS_ZXO + (size_t)T_TOK * 1024 * 2,
                 WS_K = WS_Q + (size_t)T_TOK * 512 * 2, WS_V = WS_K + (size_t)T_TOK * 512 * 2, WS_XC = WS_V + (size_t)T_TOK * 512 * 2,
                 WS_UEND = WS_XC + (size_t)T_TOK * 512 * 2;
static_assert(WS_UEND - WS_U >= (size_t)T_TOK * FF * 2, "H must fit the shared region");
constexpr size_t WS_SSQ = WS_UEND;
constexpr size_t WS_BV = WS_SSQ + (size_t)7 * T_TOK * 16 * 4, WS_AV = WS_BV + (size_t)2048 * 128 * 4, WS_CM = WS_AV + (size_t)2048 * 128 * 4,
                 WS_DN = WS_CM + (size_t)2048 * 128 * 4, WS_SC = WS_DN + (size_t)2048 * 128 * 4, WS_MS = WS_SC + (size_t)2048 * 2 * 4,
                 WS_BAR = WS_MS + (size_t)2048 * 4, WS_CS = (WS_BAR + (size_t)XCD_BAR_WORDS * 4 + 255) / 256 * 256,
                 WS_END = WS_CS + (size_t)2048 * 16384 * 2;

struct Params {
    const float* in[27];
    float* out;
    unsigned char* ws;
    int ph_lo, ph_hi;
};

typedef __bf16 bf16x2_t __attribute__((ext_vector_type(2)));
typedef float f32x2_t __attribute__((ext_vector_type(2)));
__device__ __forceinline__ unsigned pk2(float lo, float hi) { const f32x2_t v = {lo, hi}; const bf16x2_t b = __builtin_convertvector(v, bf16x2_t); return __builtin_bit_cast(unsigned, b); }
__device__ __forceinline__ float bflo(unsigned w) { return __uint_as_float(w << 16); }
__device__ __forceinline__ float bfhi(unsigned w) { return __uint_as_float(w & 0xffff0000u); }
__device__ __forceinline__ float bfel(const u32x4& v, int e) { const unsigned w = v[e >> 1]; return (e & 1) ? bfhi(w) : bflo(w); }
__device__ __forceinline__ float sigmoidf_(float x) { return __builtin_amdgcn_rcpf(1.f + __expf(-x)); }
__device__ __forceinline__ float gelu_tanh(float x) { const float y = 0.7978845608028654f * (x + 0.044715f * x * x * x); return x * __builtin_amdgcn_rcpf(1.f + __expf(-2.f * y)); }
__device__ __forceinline__ float logsig(float x) { return fminf(x, 0.f) - log1pf(expf(-fabsf(x))); }
__device__ __forceinline__ float wave_sum(float v) {
#pragma unroll
    for (int o = 1; o < 64; o <<= 1) v += __shfl_xor(v, o);
    return v;
}

__device__ __forceinline__ float row_ssq(const float* part, int row) {
    const f32x4* q = (const f32x4*)(part + (size_t)row * 16);
    const f32x4 a = q[0], b = q[1], c = q[2], d = q[3];
    return (((a[0] + a[1]) + (a[2] + a[3])) + ((b[0] + b[1]) + (b[2] + b[3]))) + (((c[0] + c[1]) + (c[2] + c[3])) + ((d[0] + d[1]) + (d[2] + d[3])));
}
__device__ __forceinline__ void wave_gemm128(f32x4 (&acc)[8], const unsigned char* Arows, const unsigned char* Brows, int fr, int fq) {
#pragma unroll
    for (int kk = 0; kk < 4; ++kk) {
        const bf16x8 a = *(const bf16x8*)(Arows + fr * MP + kk * 64 + fq * 16);
#pragma unroll
        for (int n = 0; n < 8; ++n) {
            const bf16x8 b = *(const bf16x8*)(Brows + (n * 16 + fr) * MP + kk * 64 + fq * 16);
            acc[n] = __builtin_amdgcn_mfma_f32_16x16x32_bf16(b, a, acc[n], 0, 0, 0);
        }
    }
}
__device__ __forceinline__ void zero8(f32x4 (&acc)[8]) {
#pragma unroll
    for (int n = 0; n < 8; ++n) acc[n] = (f32x4){0.f, 0.f, 0.f, 0.f};
}
__device__ __forceinline__ void load_tile(unsigned char* dst, const bf16_t* src, size_t gp, int tid) {
#pragma unroll
    for (int i = 0; i < 4; ++i) { const int id = tid + 512 * i, row = id >> 4, cc = id & 15;
        *(u32x4*)(dst + row * MP + cc * 16) = *(const u32x4*)(src + (size_t)row * gp + cc * 8); }
}

struct EpiUp {
    static constexpr bool PERM = true, AFTER_DRAIN = false;
    bf16_t* H; const PG8_LAS float* rs; int pm0;
    __device__ __forceinline__ void operator()(const f32x4 (&acc)[2][2][4][2], const pg8::Unit& u, int wr, int wc, int fr, int fq) const {
        const int row0 = u.pm * 256 + wr * 64 + fr, col = u.pn * 128 + wc * 32 + 8 * fq;
#pragma unroll
        for (int ai = 0; ai < 2; ++ai)
#pragma unroll
            for (int m = 0; m < 4; ++m) {
                const int row = row0 + ai * 128 + m * 16;
                const float rstd = rs[((u.pm - pm0) >> 3) * 256 + (row & 255)];
                float h[8];
#pragma unroll
                for (int n = 0; n < 2; ++n)
#pragma unroll
                    for (int i = 0; i < 4; ++i) { const float g = acc[ai][0][m][n][i] * rstd, uu = acc[ai][1][m][n][i] * rstd; h[4 * n + i] = g * uu * __builtin_amdgcn_rcpf(1.f + __expf(-g)); }
                u32x4 o; o[0] = pk2(h[0], h[1]); o[1] = pk2(h[2], h[3]); o[2] = pk2(h[4], h[5]); o[3] = pk2(h[6], h[7]);
                *(u32x4*)(H + (size_t)row * FF + col) = o;
            }
    }
};
template <bool RIN_F32> struct EpiRes {
    static constexpr bool PERM = true, AFTER_DRAIN = false;
    const float* Rin; bf16_t* XB; float* ssq; float scale;
    __device__ __forceinline__ void operator()(const f32x4 (&acc)[2][2][4][2], const pg8::Unit& u, int wr, int wc, int fr, int fq) const {
        static_assert(!RIN_F32, "the residual stream is bf16");
        const int row0 = u.pm * 256 + wr * 64 + fr, col0 = u.pn * 256 + wc * 32 + 8 * fq;
        u32x4 rb[4][2], ob[4][2];
#pragma unroll
        for (int m = 0; m < 4; ++m)
#pragma unroll
            for (int bj = 0; bj < 2; ++bj) rb[m][bj] = *(const u32x4*)(XB + (size_t)(row0 + m * 16) * DM + col0 + bj * 128);
#pragma unroll
        for (int ai = 0; ai < 2; ++ai) {
            float ssv[4];
#pragma unroll
            for (int m = 0; m < 4; ++m) {
                float ss = 0.f;
#pragma unroll
                for (int bj = 0; bj < 2; ++bj) {
                    const u32x4 t = rb[m][bj];
                    const f32x4 r0 = {bflo(t[0]), bfhi(t[0]), bflo(t[1]), bfhi(t[1])}, r1 = {bflo(t[2]), bfhi(t[2]), bflo(t[3]), bfhi(t[3])};
                    const f32x4 v0 = r0 + acc[ai][bj][m][0] * scale, v1 = r1 + acc[ai][bj][m][1] * scale;
                    u32x4 o; o[0] = pk2(v0[0], v0[1]); o[1] = pk2(v0[2], v0[3]); o[2] = pk2(v1[0], v1[1]); o[3] = pk2(v1[2], v1[3]);
                    ob[m][bj] = o;
                    ss += v0[0] * v0[0] + v0[1] * v0[1] + v0[2] * v0[2] + v0[3] * v0[3] + v1[0] * v1[0] + v1[1] * v1[1] + v1[2] * v1[2] + v1[3] * v1[3];
                }
                ss += __shfl_xor(ss, 16); ss += __shfl_xor(ss, 32);
                ssv[m] = ss;
            }
            if (ai == 0) {
#pragma unroll
                for (int m = 0; m < 4; ++m)
#pragma unroll
                    for (int bj = 0; bj < 2; ++bj) rb[m][bj] = *(const u32x4*)(XB + (size_t)(row0 + 128 + m * 16) * DM + col0 + bj * 128);
            }
#pragma unroll
            for (int m = 0; m < 4; ++m) {
                const int row = row0 + ai * 128 + m * 16;
#pragma unroll
                for (int bj = 0; bj < 2; ++bj) *(u32x4*)(XB + (size_t)row * DM + col0 + bj * 128) = ob[m][bj];
                if (fq == 0) ssq[(size_t)row * 16 + u.pn * 4 + wc] = ssv[m];
            }
        }
    }
};
struct EpiWin {
    static constexpr bool PERM = true, AFTER_DRAIN = false;
    bf16_t* ZUV; bf16_t* ZXO; const PG8_LAS float* rs; int pm0;
    __device__ __forceinline__ void operator()(const f32x4 (&acc)[2][2][4][2], const pg8::Unit& u, int wr, int wc, int fr, int fq) const {
        const bool act = u.pn < 4; bf16_t* dst = act ? ZUV : ZXO;
        const int row0 = u.pm * 256 + wr * 64 + fr, col0 = (u.pn & 3) * 256 + wc * 32 + 8 * fq;
#pragma unroll
        for (int ai = 0; ai < 2; ++ai)
#pragma unroll
            for (int m = 0; m < 4; ++m) {
                const int row = row0 + ai * 128 + m * 16;
                const float rstd = rs[((u.pm - pm0) >> 3) * 256 + (row & 255)];
#pragma unroll
                for (int bj = 0; bj < 2; ++bj) {
                    float h[8];
#pragma unroll
                    for (int n = 0; n < 2; ++n)
#pragma unroll
                        for (int i = 0; i < 4; ++i) { const float z = acc[ai][bj][m][n][i] * rstd; h[4 * n + i] = act ? gelu_tanh(z) : z; }
                    u32x4 o; o[0] = pk2(h[0], h[1]); o[1] = pk2(h[2], h[3]); o[2] = pk2(h[4], h[5]); o[3] = pk2(h[6], h[7]);
                    *(u32x4*)(dst + (size_t)row * 1024 + col0 + bj * 128) = o;
                }
            }
    }
};

template <class Epi>
__device__ __forceinline__ void run_gemm(unsigned char* shm, const bf16_t* A, const bf16_t* Bt, int N, int K, const Epi& E) {
    pg8::Gemm g{A, Bt, T_TOK, N, K};
    pg8::StaticOrder S; S.init(T_TOK, N, GRID, l_bid());
    pg8::gemm_phase<Epi, pg8::StaticOrder, GEMM_ALIGN, GEMM_SP2>((PG8_LAS unsigned char*)shm, g, S, E);
}

template <class Epi>
__device__ __forceinline__ void run_gemm_rs(unsigned char* shm, const bf16_t* A, const bf16_t* Bt, int N, int K, Epi& E, const float* ssq_part) {
    pg8::Gemm g{A, Bt, T_TOK, N, K};
    pg8::StaticOrder S; S.init(T_TOK, N, GRID, l_bid());
    pg8::Unit u0; if (!S.next(0, u0)) return;
    PG8_LAS float* rl = (PG8_LAS float*)(PG8_LAS unsigned char*)shm + 131072 / 4;
    const int tid = l_tid();
    for (int i = tid; i < 1024; i += 512) { const int pm = u0.pm + 8 * (i >> 8);
        if (pm < T_TOK / 256) rl[i] = rsqrtf(row_ssq(ssq_part, pm * 256 + (i & 255)) * (1.f / DM) + EPSN); }
    __syncthreads();
    E.rs = rl; E.pm0 = u0.pm;
    pg8::gemm_phase<Epi, pg8::StaticOrder, GEMM_ALIGN, GEMM_SP2>((PG8_LAS unsigned char*)shm, g, S, E);
}

__device__ __forceinline__ void transpose_item(const float* W, int K, int N, bf16_t* WT, const float* gain, int mode, float* scr, int item, int lane) {
    const int nblk = N / 64, kb = item / nblk, nb = item % nblk, k0 = 64 * kb, n0 = 64 * nb;
    const int r = lane >> 4, c4 = lane & 15;
#pragma unroll 8
    for (int i = 0; i < 16; ++i) { const int kk = 4 * i + r; f32x4 v = *(const f32x4*)(W + (size_t)(k0 + kk) * N + n0 + 4 * c4);
        if (gain) v = v * gain[k0 + kk];
        float* d = scr + kk * 65 + 4 * c4; d[0] = v[0]; d[1] = v[1]; d[2] = v[2]; d[3] = v[3]; }
    asm volatile("s_waitcnt lgkmcnt(0)" ::: "memory");
    const int c = lane & 7, nl = lane >> 3;
#pragma unroll
    for (int j = 0; j < 8; ++j) { const int n = nl + 8 * j; const float* q = scr + (8 * c) * 65 + n;
        u32x4 o; o[0] = pk2(q[0 * 65], q[1 * 65]); o[1] = pk2(q[2 * 65], q[3 * 65]); o[2] = pk2(q[4 * 65], q[5 * 65]); o[3] = pk2(q[6 * 65], q[7 * 65]);
        const int nn = n0 + n; const int row = mode == 0 ? nn : ((nn >> 7) * 256 + (mode == 2 ? 128 : 0) + (nn & 127));
        *(u32x4*)(WT + (size_t)row * K + k0 + 8 * c) = o; }
    asm volatile("s_waitcnt lgkmcnt(0)" ::: "memory");
}

__device__ __forceinline__ void phase_prologue(const Params& p, unsigned char* shm) {
    const int tid = l_tid(), lane = tid & 63, w = tid >> 6;
    const int gw = l_bid() * 8 + w, NGW = GRID * 8;
    float* scr = (float*)(shm + w * 16640);
    constexpr int I_G = (DM / 64) * (FF / 64), I_D = (FF / 64) * (DM / 64), I_IN = (DM / 64) * (2048 / 64), I_OUT = (DM / 64) * (DM / 64);
    constexpr int PER_L = 4 * I_G + 2 * I_D + I_IN + I_OUT;
    for (int it = gw; it < 2 * PER_L; it += NGW) {
        const int l = it / PER_L; int r = it % PER_L;
        unsigned char* wl = p.ws + WS_W + (size_t)l * LW_END;
        const size_t offF = (size_t)l * DM * FF, offN = (size_t)l * DM;
        if (r < I_G) { transpose_item(p.in[2] + offF, DM, FF, (bf16_t*)(wl + LW_GU1), p.in[1] + offN, 1, scr, r, lane); continue; } r -= I_G;
        if (r < I_G) { transpose_item(p.in[3] + offF, DM, FF, (bf16_t*)(wl + LW_GU1), p.in[1] + offN, 2, scr, r, lane); continue; } r -= I_G;
        if (r < I_D) { transpose_item(p.in[4] + offF, FF, DM, (bf16_t*)(wl + LW_D1), nullptr, 0, scr, r, lane); continue; } r -= I_D;
        if (r < I_IN) { transpose_item(p.in[6] + (size_t)l * DM * 2048, DM, 2048, (bf16_t*)(wl + LW_IN), p.in[5] + offN, 0, scr, r, lane); continue; } r -= I_IN;
        if (r < I_OUT) { transpose_item(p.in[21] + (size_t)l * DM * DM, DM, DM, (bf16_t*)(wl + LW_OUT), nullptr, 0, scr, r, lane); continue; } r -= I_OUT;
        if (r < I_G) { transpose_item(p.in[23] + offF, DM, FF, (bf16_t*)(wl + LW_GU2), p.in[22] + offN, 1, scr, r, lane); continue; } r -= I_G;
        if (r < I_G) { transpose_item(p.in[24] + offF, DM, FF, (bf16_t*)(wl + LW_GU2), p.in[22] + offN, 2, scr, r, lane); continue; } r -= I_G;
        transpose_item(p.in[25] + offF, FF, DM, (bf16_t*)(wl + LW_D2), nullptr, 0, scr, r, lane);
    }
    {
        const float* x = p.in[0]; bf16_t* XB = (bf16_t*)(p.ws + WS_XB); float* ssq0 = (float*)(p.ws + WS_SSQ);
        for (int row = gw; row < T_TOK; row += NGW) {
            const f32x4* xr = (const f32x4*)(x + (size_t)row * DM) + lane;
            u32x2* o = (u32x2*)(XB + (size_t)row * DM) + lane;
            float s = 0.f;
#pragma unroll
            for (int j = 0; j < 4; ++j) { const f32x4 v = xr[64 * j]; s += v[0] * v[0] + v[1] * v[1] + v[2] * v[2] + v[3] * v[3];
                u32x2 q; q[0] = pk2(v[0], v[1]); q[1] = pk2(v[2], v[3]); o[64 * j] = q; }
            s = wave_sum(s);
            if (lane < 16) ssq0[(size_t)row * 16 + lane] = lane == 0 ? s : 0.f;
        }
    }
    const int gt = l_bid() * 512 + tid, NT = GRID * 512;
    for (int i = gt; i < 2 * 4 * 128 * 128 / 4; i += NT) {
        const int l = i / (4 * 128 * 128 / 4), r = i % (4 * 128 * 128 / 4);
        const f32x4 v = ((const f32x4*)p.in[8])[i]; u32x2 q; q[0] = pk2(v[0], v[1]); q[1] = pk2(v[2], v[3]);
        ((u32x2*)(p.ws + WS_W + (size_t)l * LW_END + LW_SGU))[r] = q;
    }
    for (int i = gt; i < 2 * 16 * 1536; i += NT) {
        const int l = i / (16 * 1536), r = i % (16 * 1536), n = r / 1536, k = r % 1536;
        const float v = n < 8 ? p.in[15][((size_t)l * 1536 + k) * 8 + n] : p.in[17][((size_t)l * 1536 + k) * 8 + (n - 8)];
        ((bf16_t*)(p.ws + WS_W + (size_t)l * LW_END + LW_GT))[r] = (bf16_t)(pk2(v, 0.f) & 0xffffu);
    }
}

__device__ __forceinline__ void phase_prep(const Params& p, int l, unsigned char* shm) {
    const int tid = l_tid(), lane = tid & 63, w = tid >> 6, fr = lane & 15, fq = lane >> 4;
    const bf16_t* ZXO = (const bf16_t*)(p.ws + WS_ZXO);
    bf16_t* Qb = (bf16_t*)(p.ws + WS_Q); bf16_t* Kb = (bf16_t*)(p.ws + WS_K); bf16_t* Vb = (bf16_t*)(p.ws + WS_V); bf16_t* XCb = (bf16_t*)(p.ws + WS_XC);
    const float* conv_w = p.in[10] + (size_t)l * 5 * 512; const float* conv_b = p.in[11] + (size_t)l * 512;
    const float* wq = p.in[12] + (size_t)l * 128 * 16; const float* wk = p.in[13] + (size_t)l * 128 * 16; const float* wv = p.in[14] + (size_t)l * 128 * 16;
    const bf16_t* WgT = (const bf16_t*)(p.ws + WS_W + (size_t)l * LW_END + LW_GT);
    const float* gbf = p.in[16] + l * 8; const float* gbb = p.in[18] + l * 8;
    float* bvec = (float*)(p.ws + WS_BV); float* avec = (float*)(p.ws + WS_AV); float* cmvec = (float*)(p.ws + WS_CM); float* scal = (float*)(p.ws + WS_SC);
    constexpr int TP = 784;
    unsigned char* tile = shm; float* Gs = (float*)(shm + 128 * TP); unsigned char* wgl = shm + 128 * TP + 8192;
    for (int u = l_bid(); u < 256; u += GRID) {
        const int c = u & 63; const size_t T0 = (size_t)u * 128;
        f32x4 gacc = {0.f, 0.f, 0.f, 0.f};
        for (int hh = 0; hh < 4; ++hh) {
            const int g = tid & 31, tq = tid >> 5, ch = hh * 128 + 4 * g;
            f32x4 cw[5];
#pragma unroll
            for (int j = 0; j < 5; ++j) cw[j] = *(const f32x4*)(conv_w + j * 512 + ch);
            const f32x4 cb = *(const f32x4*)(conv_b + ch);
            f32x4 wq4[4], wk4[4], wv4[4];
#pragma unroll
            for (int i = 0; i < 4; ++i) { const size_t o = (size_t)(hh * 32 + g) * 16 + i * 4; wq4[i] = *(const f32x4*)(wq + o); wk4[i] = *(const f32x4*)(wk + o); wv4[i] = *(const f32x4*)(wv + o); }
            u32x4 wsl[2];
#pragma unroll
            for (int q = 0; q < 2; ++q) { const int ii = tid + 512 * q; if (ii < 768) { const int n = ii / 48, rem = ii % 48, part = rem >> 4, c16 = rem & 15;
                wsl[q] = *(const u32x4*)(WgT + (size_t)n * 1536 + part * 512 + hh * 128 + c16 * 8); } }
#pragma unroll
            for (int i = 0; i < 8; ++i) {
                const int t = tq + 16 * i;
                f32x4 xs[5];
#pragma unroll
                for (int j = 0; j < 5; ++j) {
                    const int pos = c * 128 + t + j - 2;
                    if (pos >= 0 && pos < SEQ) { const u32x2 r = *(const u32x2*)(ZXO + (T0 + t + j - 2) * 1024 + ch);
                        xs[j] = (f32x4){bflo(r[0]), bfhi(r[0]), bflo(r[1]), bfhi(r[1])}; }
                    else xs[j] = (f32x4){0.f, 0.f, 0.f, 0.f};
                }
                f32x4 a = cb;
#pragma unroll
                for (int j = 0; j < 5; ++j) a += cw[j] * xs[j];
                f32x4 xc;
#pragma unroll
                for (int e = 0; e < 4; ++e) xc[e] = a[e] * __builtin_amdgcn_rcpf(1.f + __expf(-a[e]));
                f32x4 q = xc[0] * wq4[0] + xc[1] * wq4[1] + xc[2] * wq4[2] + xc[3] * wq4[3];
                f32x4 k = (xc[0] * wk4[0] + xc[1] * wk4[1] + xc[2] * wk4[2] + xc[3] * wk4[3]) * 0.08838834764831845f;
                f32x4 v = xs[2][0] * wv4[0] + xs[2][1] * wv4[1] + xs[2][2] * wv4[2] + xs[2][3] * wv4[3];
                u32x2 qp, kp, vp, xp;
                qp[0] = pk2(q[0], q[1]); qp[1] = pk2(q[2], q[3]); kp[0] = pk2(k[0], k[1]); kp[1] = pk2(k[2], k[3]);
                vp[0] = pk2(v[0], v[1]); vp[1] = pk2(v[2], v[3]); xp[0] = pk2(xc[0], xc[1]); xp[1] = pk2(xc[2], xc[3]);
                const size_t go = (T0 + t) * 512 + ch;
                *(u32x2*)(Qb + go) = qp; *(u32x2*)(Kb + go) = kp; *(u32x2*)(Vb + go) = vp; *(u32x2*)(XCb + go) = xp;
                unsigned char* tr = tile + t * TP + g * 8;
                *(u32x2*)(tr) = qp; *(u32x2*)(tr + 256) = kp; *(u32x2*)(tr + 512) = vp;
            }
#pragma unroll
            for (int q = 0; q < 2; ++q) { const int ii = tid + 512 * q; if (ii < 768) { const int n = ii / 48, rem = ii % 48, part = rem >> 4, c16 = rem & 15;
                *(u32x4*)(wgl + n * TP + part * 256 + c16 * 16) = wsl[q]; } }
            __syncthreads();
#pragma unroll
            for (int kk = 0; kk < 12; ++kk) {
                const bf16x8 a = *(const bf16x8*)(tile + (16 * w + fr) * TP + kk * 64 + fq * 16);
                const bf16x8 b = *(const bf16x8*)(wgl + fr * TP + kk * 64 + fq * 16);
                gacc = __builtin_amdgcn_mfma_f32_16x16x32_bf16(b, a, gacc, 0, 0, 0);
            }
            __syncthreads();
        }
        { const f32x4 bias = (fq < 2) ? *(const f32x4*)(gbf + fq * 4) : *(const f32x4*)(gbb + (fq - 2) * 4);
          *(f32x4*)(Gs + (16 * w + fr) * 16 + fq * 4) = gacc + bias; }
        __syncthreads();
        {
            const int dir = w >> 2, hs = w & 3;
            const int e0 = 2 * lane, e1 = e0 + 1, p0 = dir ? 127 - e0 : e0, p1 = dir ? 127 - e1 : e1;
            const float ig0 = Gs[p0 * 16 + dir * 8 + hs], ig1 = Gs[p1 * 16 + dir * 8 + hs];
            const float lf0 = logsig(Gs[p0 * 16 + dir * 8 + 4 + hs]), lf1 = logsig(Gs[p1 * 16 + dir * 8 + 4 + hs]);
            const float s1 = lf0 + lf1; float incl = s1;
#pragma unroll
            for (int off = 1; off < 64; off <<= 1) { const float t = __shfl_up(incl, off); if (lane >= off) incl += t; }
            const float excl = incl - s1, b0 = excl + lf0, b1 = excl + s1, btot = __shfl(incl, 63);
            const float a0 = ig0 - b0, a1 = ig1 - b1, c1 = fmaxf(a0, a1); float mx = c1;
#pragma unroll
            for (int off = 1; off < 64; off <<= 1) { const float t = __shfl_up(mx, off); if (lane >= off) mx = fmaxf(mx, t); }
            float ex = __shfl_up(mx, 1); if (lane == 0) ex = -INFINITY;
            const float cm0 = fmaxf(ex, a0), cm1 = fmaxf(ex, c1), amax = __shfl(mx, 63);
            const size_t idx = ((size_t)(u * 4 + hs)) * 2 + dir;
            bvec[idx * 128 + p0] = b0; bvec[idx * 128 + p1] = b1; avec[idx * 128 + p0] = a0; avec[idx * 128 + p1] = a1;
            cmvec[idx * 128 + p0] = cm0; cmvec[idx * 128 + p1] = cm1;
            if (lane == 0) { scal[idx * 2] = btot; scal[idx * 2 + 1] = amax; }
        }
        __syncthreads();
    }
}

__device__ __forceinline__ void load_tile_T(unsigned char* dst, const bf16_t* src, size_t gp, int tid) {
    const int sp = tid & 63, cg0 = tid >> 6;
#pragma unroll
    for (int it = 0; it < 2; ++it) {
        const int chunk = cg0 + 8 * it;
        const bf16_t* sp0 = src + (size_t)(2 * sp) * gp + chunk * 8;
        const u32x4 r0 = *(const u32x4*)sp0, r1 = *(const u32x4*)(sp0 + gp);
#pragma unroll
        for (int e = 0; e < 8; ++e) {
            const unsigned w0 = r0[e >> 1], w1 = r1[e >> 1];
            const unsigned lo = (e & 1) ? (w0 >> 16) : (w0 & 0xffffu), hi = (e & 1) ? (w1 & 0xffff0000u) : (w1 << 16);
            *(unsigned*)(dst + (chunk * 8 + e) * MP + sp * 4) = lo | hi;
        }
    }
}

struct StPre { u32x4 k[2][2], v[2][2]; float a; };
__device__ __forceinline__ void state_issue(StPre& r, const Params& p, int unit, int tid) {
    const int u = unit >> 2, hh = unit & 3; const size_t T0 = (size_t)u * 128;
    const bf16_t* Kb = (const bf16_t*)(p.ws + WS_K); const bf16_t* Vb = (const bf16_t*)(p.ws + WS_V);
    const float* avec = (const float*)(p.ws + WS_AV); const float* scal = (const float*)(p.ws + WS_SC);
    const int sp = tid & 63, cg0 = tid >> 6;
#pragma unroll
    for (int it = 0; it < 2; ++it) { const size_t o = (T0 + 2 * sp) * 512 + hh * 128 + (cg0 + 8 * it) * 8;
        r.k[it][0] = *(const u32x4*)(Kb + o); r.k[it][1] = *(const u32x4*)(Kb + o + 512);
        r.v[it][0] = *(const u32x4*)(Vb + o); r.v[it][1] = *(const u32x4*)(Vb + o + 512); }
    const int t2 = tid & 255, dir = t2 >> 7, s = t2 & 127; const size_t idx = (size_t)unit * 2 + dir;
    r.a = avec[idx * 128 + s] - scal[idx * 2 + 1];
}
__device__ __forceinline__ void phase_state(const Params& p, unsigned char* shm) {
    const int tid = l_tid(), lane = tid & 63, w = tid >> 6, fr = lane & 15, fq = lane >> 4;
    bf16_t* CS = (bf16_t*)(p.ws + WS_CS); float* DN = (float*)(p.ws + WS_DN);
    unsigned char* VT = shm; unsigned char* KTF = shm + MBUF; unsigned char* KTB = shm + 2 * MBUF; float* wk = (float*)(shm + 4 * MBUF);
    int unit = 4 * l_bid(); const int uend = unit + 4;
    StPre r;
    if (unit < 1024) state_issue(r, p, unit, tid);
    for (; unit < uend && unit < 1024; ++unit) {
        if (tid < 256) wk[tid] = __expf(r.a);
        __syncthreads();
        {
            const int sp = tid & 63, cg0 = tid >> 6;
            const float wf0 = wk[2 * sp], wf1 = wk[2 * sp + 1], wb0 = wk[128 + 2 * sp], wb1 = wk[128 + 2 * sp + 1];
#pragma unroll
            for (int it = 0; it < 2; ++it) {
                const int chunk = cg0 + 8 * it;
#pragma unroll
                for (int e = 0; e < 8; ++e) {
                    const unsigned w0 = r.v[it][0][e >> 1], w1 = r.v[it][1][e >> 1];
                    const unsigned lo = (e & 1) ? (w0 >> 16) : (w0 & 0xffffu), hi = (e & 1) ? (w1 & 0xffff0000u) : (w1 << 16);
                    *(unsigned*)(VT + (chunk * 8 + e) * MP + sp * 4) = lo | hi;
                    const float k0 = bfel(r.k[it][0], e), k1 = bfel(r.k[it][1], e);
                    *(unsigned*)(KTF + (chunk * 8 + e) * MP + sp * 4) = pk2(k0 * wf0, k1 * wf1);
                    *(unsigned*)(KTB + (chunk * 8 + e) * MP + sp * 4) = pk2(k0 * wb0, k1 * wb1);
                }
            }
        }
        __syncthreads();
        if (unit + 1 < uend) state_issue(r, p, unit + 1, tid);
#pragma unroll
        for (int dir = 0; dir < 2; ++dir) {
            f32x4 acc[8]; zero8(acc);
            wave_gemm128(acc, VT + 16 * w * MP, dir ? KTB : KTF, fr, fq);
            bf16_t* dst = CS + ((size_t)unit * 2 + dir) * 16384 + (16 * w + fr) * 128 + 4 * fq;
#pragma unroll
            for (int n = 0; n < 8; ++n) { u32x2 o; o[0] = pk2(acc[n][0], acc[n][1]); o[1] = pk2(acc[n][2], acc[n][3]); *(u32x2*)(dst + n * 16) = o; }
        }
        {
            const int k = tid >> 2, part = tid & 3;
#pragma unroll
            for (int dir = 0; dir < 2; ++dir) {
                const unsigned char* base = (dir ? KTB : KTF) + k * MP + part * 64;
                float sm = 0.f;
#pragma unroll
                for (int i = 0; i < 4; ++i) { const u32x4 q = *(const u32x4*)(base + i * 16);
#pragma unroll
                    for (int e = 0; e < 4; ++e) sm += bflo(q[e]) + bfhi(q[e]); }
                sm += __shfl_xor(sm, 1); sm += __shfl_xor(sm, 2);
                if (part == 0) DN[((size_t)unit * 2 + dir) * 128 + k] = sm;
            }
        }
        __syncthreads();
    }
}

struct SgPre { u32x4 v[2][2]; };
__device__ __forceinline__ void sgu_issue(SgPre& r, const Params& p, int unit, int tid) {
    const int u = unit >> 2, hh = unit & 3; const size_t T0 = (size_t)u * 128;
    const bf16_t* ZUV = (const bf16_t*)(p.ws + WS_ZUV);
    const int sp = tid & 63, cg0 = tid >> 6;
#pragma unroll
    for (int it = 0; it < 2; ++it) { const size_t o = (T0 + 2 * sp) * 1024 + 512 + hh * 128 + (cg0 + 8 * it) * 8;
        r.v[it][0] = *(const u32x4*)(ZUV + o); r.v[it][1] = *(const u32x4*)(ZUV + o + 1024); }
}
__device__ __forceinline__ void phase_sgu(const Params& p, int l, unsigned char* shm) {
    const int tid = l_tid(), lane = tid & 63, w = tid >> 6, fr = lane & 15, fq = lane >> 4;
    bf16_t* ZUV = (bf16_t*)(p.ws + WS_ZUV);
    unsigned char* WS = shm; unsigned char* VHT = shm + MBUF; float* part = (float*)(shm + 4 * MBUF);
    const int G = GRID; int unit = l_bid();
    if (unit >= 1024) return;
    const int hh = unit & 3;
    const bf16_t* Wsb = (const bf16_t*)(p.ws + WS_W + (size_t)l * LW_END + LW_SGU);
    const float* gnb = p.in[7] + (size_t)l * 512; const float* bsb = p.in[9] + (size_t)l * 512;
    SgPre r;
    sgu_issue(r, p, unit, tid);
    int staged = -1;
    for (; unit < 1024; unit += G) {
        const int u = unit >> 2, hu = unit & 3; const size_t T0 = (size_t)u * 128;
        if (staged != hu) { load_tile(WS, Wsb + (size_t)hu * 128 * 128, 128, tid); staged = hu; }
        const int sp = tid & 63, cg0 = tid >> 6;
        {
            float s0 = 0.f, q0 = 0.f, s1 = 0.f, q1 = 0.f;
#pragma unroll
            for (int it = 0; it < 2; ++it)
#pragma unroll
                for (int e = 0; e < 4; ++e) { const float a0 = bflo(r.v[it][0][e]), a1 = bfhi(r.v[it][0][e]), b0 = bflo(r.v[it][1][e]), b1 = bfhi(r.v[it][1][e]);
                    s0 += a0 + a1; q0 += a0 * a0 + a1 * a1; s1 += b0 + b1; q1 += b0 * b0 + b1 * b1; }
            *(f32x4*)(part + (cg0 * 128 + 2 * sp) * 2) = (f32x4){s0, q0, s1, q1};
        }
        __syncthreads();
        {
            float s0 = 0.f, q0 = 0.f, s1 = 0.f, q1 = 0.f;
#pragma unroll
            for (int ww = 0; ww < 8; ++ww) { const f32x4 t = *(const f32x4*)(part + (ww * 128 + 2 * sp) * 2); s0 += t[0]; q0 += t[1]; s1 += t[2]; q1 += t[3]; }
            const float mu0 = s0 * (1.f / 128.f), mu1 = s1 * (1.f / 128.f);
            const float rs0 = rsqrtf(fmaxf(q0 * (1.f / 128.f) - mu0 * mu0, 0.f) + EPSN), rs1 = rsqrtf(fmaxf(q1 * (1.f / 128.f) - mu1 * mu1, 0.f) + EPSN);
            const float* gn = gnb + hu * 128;
#pragma unroll
            for (int it = 0; it < 2; ++it) {
                const int chunk = cg0 + 8 * it;
                const f32x4 g0 = *(const f32x4*)(gn + chunk * 8), g1 = *(const f32x4*)(gn + chunk * 8 + 4);
#pragma unroll
                for (int e = 0; e < 8; ++e) {
                    const float gg = e < 4 ? g0[e & 3] : g1[e & 3];
                    const float a = (bfel(r.v[it][0], e) - mu0) * rs0 * gg, b = (bfel(r.v[it][1], e) - mu1) * rs1 * gg;
                    *(unsigned*)(VHT + (chunk * 8 + e) * MP + sp * 4) = pk2(a, b);
                }
            }
        }
        __syncthreads();
        if (unit + G < 1024) sgu_issue(r, p, unit + G, tid);
        const int pr = 16 * w + fr; const float bias = bsb[hu * 128 + pr];
        bf16_t* up = ZUV + (T0 + pr) * 1024 + hu * 128 + 4 * fq;
        u32x2 uu[8];
#pragma unroll
        for (int n = 0; n < 8; ++n) uu[n] = *(const u32x2*)(up + n * 16);
        f32x4 acc[8]; zero8(acc);
        wave_gemm128(acc, WS + 16 * w * MP, VHT, fr, fq);
        {
#pragma unroll
            for (int n = 0; n < 8; ++n) {
                u32x2 o; o[0] = pk2(bflo(uu[n][0]) * (acc[n][0] + bias), bfhi(uu[n][0]) * (acc[n][1] + bias));
                o[1] = pk2(bflo(uu[n][1]) * (acc[n][2] + bias), bfhi(uu[n][1]) * (acc[n][3] + bias));
                *(u32x2*)(up + n * 16) = o;
            }
        }
        __syncthreads();
    }
}

__device__ __forceinline__ void phase_scan_sgu(const Params& p, int l, unsigned char* shm) {
    static_assert(GRID * 512 == 32 * 4096 && 1024 / GRID == 4, "one scan item per thread, four SGU units per block");
    const int tid = l_tid(), lane = tid & 63, w = tid >> 6, fr = lane & 15, fq = lane >> 4;
    bf16_t* ZUV = (bf16_t*)(p.ws + WS_ZUV);
    unsigned char* WS = shm; unsigned char* VHT = shm + MBUF; float* part = (float*)(shm + 4 * MBUF);
    const int G = GRID; int unit = l_bid();
    if (unit >= 1024) return;
    const int hh = unit & 3;
    const bf16_t* Wsb = (const bf16_t*)(p.ws + WS_W + (size_t)l * LW_END + LW_SGU);
    const float* gnb = p.in[7] + (size_t)l * 512; const float* bsb = p.in[9] + (size_t)l * 512;
    SgPre r;
    sgu_issue(r, p, unit, tid);
    int staged = -1;
    bf16_t* CS = (bf16_t*)(p.ws + WS_CS); float* DN = (float*)(p.ws + WS_DN);
    const float* scal = (const float*)(p.ws + WS_SC); float* mst = (float*)(p.ws + WS_MS);
    const int chain = l_bid() >> 3, q4 = (l_bid() & 7) * 512 + tid, sb = chain >> 3, shh = (chain >> 1) & 3, sdir = chain & 1;
    const bool has_n = q4 < 128;
    float C0 = 0.f, C1 = 0.f, C2 = 0.f, C3 = 0.f, nn = 0.f;
    float* cf1 = (float*)(shm + 2 * MBUF); float* cf2 = cf1 + 64; float* cmp = cf1 + 128;
    if (tid < 64) { const int st = tid, c = sdir ? 63 - st : st; const size_t idx = ((size_t)((sb * 64 + c) * 4 + shh)) * 2 + sdir; cf1[st] = scal[idx * 2]; cf2[st] = scal[idx * 2 + 1]; }
    __syncthreads();
    if (tid == 0) { float sm = 0.f;
#pragma unroll 8
        for (int st = 0; st < 64; ++st) { const float bt = cf1[st], am = cf2[st], mm = fmaxf(sm, am);
            cmp[st] = sm; cf1[st] = __expf(sm - mm); cf2[st] = __expf(am - mm); sm = bt + mm; } }
    __syncthreads();
    int kb = 0;
    for (; unit < 1024; unit += G, ++kb) {
        u32x2 sd[8]; float sdn[8];
#define SCAN_ISSUE(ST0) _Pragma("unroll") for (int jj = 0; jj < 8; ++jj) { const int st = (ST0) + jj, c = sdir ? 63 - st : st; const size_t idx = ((size_t)((sb * 64 + c) * 4 + shh)) * 2 + sdir; \
            sd[jj] = *(const u32x2*)(CS + idx * 16384 + q4 * 4); sdn[jj] = has_n ? DN[idx * 128 + q4] : 0.f; }
#define SCAN_CONSUME(ST0) _Pragma("unroll") for (int jj = 0; jj < 8; ++jj) { const int st = (ST0) + jj, c = sdir ? 63 - st : st; const size_t idx = ((size_t)((sb * 64 + c) * 4 + shh)) * 2 + sdir; \
            u32x2 o; o[0] = pk2(C0, C1); o[1] = pk2(C2, C3); *(u32x2*)(CS + idx * 16384 + q4 * 4) = o; \
            if (has_n) DN[idx * 128 + q4] = nn; \
            if (q4 == 0) mst[idx] = cmp[st]; \
            const float f1 = cf1[st], f2 = cf2[st]; \
            C0 = f1 * C0 + f2 * bflo(sd[jj][0]); C1 = f1 * C1 + f2 * bfhi(sd[jj][0]); C2 = f1 * C2 + f2 * bflo(sd[jj][1]); C3 = f1 * C3 + f2 * bfhi(sd[jj][1]); \
            nn = f1 * nn + f2 * sdn[jj]; }
        SCAN_ISSUE(16 * kb)
        const int u = unit >> 2, hu = unit & 3; const size_t T0 = (size_t)u * 128;
        if (staged != hu) { load_tile(WS, Wsb + (size_t)hu * 128 * 128, 128, tid); staged = hu; }
        const int sp = tid & 63, cg0 = tid >> 6;
        {
            float s0 = 0.f, q0 = 0.f, s1 = 0.f, q1 = 0.f;
#pragma unroll
            for (int it = 0; it < 2; ++it)
#pragma unroll
                for (int e = 0; e < 4; ++e) { const float a0 = bflo(r.v[it][0][e]), a1 = bfhi(r.v[it][0][e]), b0 = bflo(r.v[it][1][e]), b1 = bfhi(r.v[it][1][e]);
                    s0 += a0 + a1; q0 += a0 * a0 + a1 * a1; s1 += b0 + b1; q1 += b0 * b0 + b1 * b1; }
            *(f32x4*)(part + (cg0 * 128 + 2 * sp) * 2) = (f32x4){s0, q0, s1, q1};
        }
        __syncthreads();
        {
            float s0 = 0.f, q0 = 0.f, s1 = 0.f, q1 = 0.f;
#pragma unroll
            for (int ww = 0; ww < 8; ++ww) { const f32x4 t = *(const f32x4*)(part + (ww * 128 + 2 * sp) * 2); s0 += t[0]; q0 += t[1]; s1 += t[2]; q1 += t[3]; }
            const float mu0 = s0 * (1.f / 128.f), mu1 = s1 * (1.f / 128.f);
            const float rs0 = rsqrtf(fmaxf(q0 * (1.f / 128.f) - mu0 * mu0, 0.f) + EPSN), rs1 = rsqrtf(fmaxf(q1 * (1.f / 128.f) - mu1 * mu1, 0.f) + EPSN);
            const float* gn = gnb + hu * 128;
#pragma unroll
            for (int it = 0; it < 2; ++it) {
                const int chunk = cg0 + 8 * it;
                const f32x4 g0 = *(const f32x4*)(gn + chunk * 8), g1 = *(const f32x4*)(gn + chunk * 8 + 4);
#pragma unroll
                for (int e = 0; e < 8; ++e) {
                    const float gg = e < 4 ? g0[e & 3] : g1[e & 3];
                    const float a = (bfel(r.v[it][0], e) - mu0) * rs0 * gg, b = (bfel(r.v[it][1], e) - mu1) * rs1 * gg;
                    *(unsigned*)(VHT + (chunk * 8 + e) * MP + sp * 4) = pk2(a, b);
                }
            }
        }
        __syncthreads();
        SCAN_CONSUME(16 * kb)
        SCAN_ISSUE(16 * kb + 8)
        if (unit + G < 1024) sgu_issue(r, p, unit + G, tid);
        const int pr = 16 * w + fr; const float bias = bsb[hu * 128 + pr];
        bf16_t* up = ZUV + (T0 + pr) * 1024 + hu * 128 + 4 * fq;
        u32x2 uu[8];
#pragma unroll
        for (int n = 0; n < 8; ++n) uu[n] = *(const u32x2*)(up + n * 16);
        f32x4 acc[8]; zero8(acc);
        wave_gemm128(acc, WS + 16 * w * MP, VHT, fr, fq);
        {
#pragma unroll
            for (int n = 0; n < 8; ++n) {
                u32x2 o; o[0] = pk2(bflo(uu[n][0]) * (acc[n][0] + bias), bfhi(uu[n][0]) * (acc[n][1] + bias));
                o[1] = pk2(bflo(uu[n][1]) * (acc[n][2] + bias), bfhi(uu[n][1]) * (acc[n][3] + bias));
                *(u32x2*)(up + n * 16) = o;
            }
        }
        __syncthreads();
        SCAN_CONSUME(16 * kb + 8)
#undef SCAN_ISSUE
#undef SCAN_CONSUME
    }
}

__device__ __forceinline__ void phase_scan(const Params& p) {
    const int gt = l_bid() * 512 + l_tid(), NT = GRID * 512;
    bf16_t* CS = (bf16_t*)(p.ws + WS_CS); float* DN = (float*)(p.ws + WS_DN);
    const float* scal = (const float*)(p.ws + WS_SC); float* mst = (float*)(p.ws + WS_MS);
    for (int item = gt; item < 32 * 4096; item += NT) {
        const int chain = item >> 12, q4 = item & 4095, b = chain >> 3, hh = (chain >> 1) & 3, dir = chain & 1;
        float m = 0.f, C0 = 0.f, C1 = 0.f, C2 = 0.f, C3 = 0.f;
        for (int s0 = 0; s0 < 64; s0 += 8) {
            u32x2 d[8]; float bt[8], am[8];
#pragma unroll
            for (int j = 0; j < 8; ++j) { const int st = s0 + j, c = dir ? 63 - st : st; const size_t idx = ((size_t)((b * 64 + c) * 4 + hh)) * 2 + dir;
                d[j] = *(const u32x2*)(CS + idx * 16384 + q4 * 4); bt[j] = scal[idx * 2]; am[j] = scal[idx * 2 + 1]; }
#pragma unroll
            for (int j = 0; j < 8; ++j) { const int st = s0 + j, c = dir ? 63 - st : st; const size_t idx = ((size_t)((b * 64 + c) * 4 + hh)) * 2 + dir;
                u32x2 o; o[0] = pk2(C0, C1); o[1] = pk2(C2, C3); *(u32x2*)(CS + idx * 16384 + q4 * 4) = o;
                if (q4 == 0) mst[idx] = m;
                const float mm = fmaxf(m, am[j]), f1 = __expf(m - mm), f2 = __expf(am[j] - mm);
                C0 = f1 * C0 + f2 * bflo(d[j][0]); C1 = f1 * C1 + f2 * bfhi(d[j][0]); C2 = f1 * C2 + f2 * bflo(d[j][1]); C3 = f1 * C3 + f2 * bfhi(d[j][1]);
                m = bt[j] + mm; }
        }
    }
    for (int item = gt; item < 32 * 128; item += NT) {
        const int chain = item >> 7, k = item & 127, b = chain >> 3, hh = (chain >> 1) & 3, dir = chain & 1;
        float m = 0.f, n = 0.f;
        for (int s0 = 0; s0 < 64; s0 += 8) {
            float d[8], bt[8], am[8];
#pragma unroll
            for (int j = 0; j < 8; ++j) { const int st = s0 + j, c = dir ? 63 - st : st; const size_t idx = ((size_t)((b * 64 + c) * 4 + hh)) * 2 + dir;
                d[j] = DN[idx * 128 + k]; bt[j] = scal[idx * 2]; am[j] = scal[idx * 2 + 1]; }
#pragma unroll
            for (int j = 0; j < 8; ++j) { const int st = s0 + j, c = dir ? 63 - st : st; const size_t idx = ((size_t)((b * 64 + c) * 4 + hh)) * 2 + dir;
                DN[idx * 128 + k] = n;
                const float mm = fmaxf(m, am[j]), f1 = __expf(m - mm), f2 = __expf(am[j] - mm);
                n = f1 * n + f2 * d[j]; m = bt[j] + mm; }
        }
    }
}

struct QKPre { u32x4 q[4], k[4], cf[4], v[2][2]; float va, vM, vb, vn, m; };
__device__ __forceinline__ void issue_qk(QKPre& r, const Params& p, int unit, int tid) {
    const int u = unit >> 2, hh = unit & 3; const size_t ub = (size_t)u * 128 * 512 + hh * 128;
    const bf16_t* Qb = (const bf16_t*)(p.ws + WS_Q) + ub; const bf16_t* Kb = (const bf16_t*)(p.ws + WS_K) + ub; const bf16_t* Vb = (const bf16_t*)(p.ws + WS_V) + ub;
    const bf16_t* Cf = (const bf16_t*)(p.ws + WS_CS) + (size_t)unit * 2 * 16384;
#pragma unroll
    for (int i = 0; i < 4; ++i) { const int id = tid + 512 * i, row = id >> 4, cc = id & 15;
        r.q[i] = *(const u32x4*)(Qb + row * 512 + cc * 8); r.k[i] = *(const u32x4*)(Kb + row * 512 + cc * 8); r.cf[i] = *(const u32x4*)(Cf + row * 128 + cc * 8); }
    const int sp = tid & 63, cg0 = tid >> 6;
#pragma unroll
    for (int it = 0; it < 2; ++it) { const bf16_t* vp = Vb + (2 * sp) * 512 + (cg0 + 8 * it) * 8; r.v[it][0] = *(const u32x4*)vp; r.v[it][1] = *(const u32x4*)(vp + 512); }
    const int t2 = tid & 255; const int vo = unit * 256 + t2;
    const float m = ((const float*)(p.ws + WS_MS))[unit * 2 + (t2 >> 7)];
    r.va = ((const float*)(p.ws + WS_AV))[vo]; r.vM = fmaxf(m, ((const float*)(p.ws + WS_CM))[vo]); r.vb = ((const float*)(p.ws + WS_BV))[vo]; r.vn = ((const float*)(p.ws + WS_DN))[vo]; r.m = m;
}
__device__ __forceinline__ void unit_out(const Params& p, int l, unsigned char* shm, int unit, QKPre& pre, int next) {
    const int tid = l_tid(), lane = tid & 63, w = tid >> 6, fr = lane & 15, fq = lane >> 4;
    const int u = unit >> 2, hh = unit & 3; const size_t T0 = (size_t)u * 128;
    const bf16_t* Qb = (const bf16_t*)(p.ws + WS_Q); const bf16_t* Kb = (const bf16_t*)(p.ws + WS_K); const bf16_t* Vb = (const bf16_t*)(p.ws + WS_V);
    const bf16_t* XCb = (const bf16_t*)(p.ws + WS_XC); const bf16_t* ZXO = (const bf16_t*)(p.ws + WS_ZXO); bf16_t* ZUV = (bf16_t*)(p.ws + WS_ZUV);
    const bf16_t* CS = (const bf16_t*)(p.ws + WS_CS); const float* DN = (const float*)(p.ws + WS_DN);
    const float* bvec = (const float*)(p.ws + WS_BV); const float* avec = (const float*)(p.ws + WS_AV); const float* cmvec = (const float*)(p.ws + WS_CM);
    const float* mst = (const float*)(p.ws + WS_MS);
    const float* mhn = p.in[19] + (size_t)l * 512; const float* skip = p.in[20] + (size_t)l * 512;
    unsigned char* QS = shm; unsigned char* KS = shm + MBUF; unsigned char* VT = shm + 2 * MBUF; unsigned char* CX = shm + 3 * MBUF;
    float* vec = (float*)(shm + 4 * MBUF);
#pragma unroll
    for (int i = 0; i < 4; ++i) { const int id = tid + 512 * i, row = id >> 4, cc = id & 15; *(u32x4*)(QS + row * MP + cc * 16) = pre.q[i]; *(u32x4*)(KS + row * MP + cc * 16) = pre.k[i]; }
#pragma unroll
    for (int i = 0; i < 4; ++i) { const int id = tid + 512 * i, row = id >> 4, cc = id & 15; *(u32x4*)(CX + row * MP + cc * 16) = pre.cf[i]; }
    {
        const int sp = tid & 63, cg0 = tid >> 6;
#pragma unroll
        for (int it = 0; it < 2; ++it)
#pragma unroll
            for (int e = 0; e < 8; ++e) {
                const unsigned w0 = pre.v[it][0][e >> 1], w1 = pre.v[it][1][e >> 1];
                const unsigned lo = (e & 1) ? (w0 >> 16) : (w0 & 0xffffu), hi = (e & 1) ? (w1 & 0xffff0000u) : (w1 << 16);
                *(unsigned*)(VT + ((cg0 + 8 * it) * 8 + e) * MP + sp * 4) = lo | hi;
            }
    }
    if (tid < 256) { const int dir = tid >> 7, s = tid & 127;
        vec[dir * 128 + s] = pre.va; vec[256 + dir * 128 + s] = pre.vM; vec[512 + dir * 128 + s] = pre.vb; vec[768 + dir * 128 + s] = pre.vn;
        if (s == 0) vec[1280 + dir] = pre.m; }
    __syncthreads();
    {
        const int j = tid >> 2, part = tid & 3;
        const unsigned char* qp = QS + j * MP + part * 64;
        float df = 0.f, db = 0.f;
#pragma unroll
        for (int i = 0; i < 4; ++i) { const u32x4 r = *(const u32x4*)(qp + i * 16);
#pragma unroll
            for (int e = 0; e < 4; ++e) { const int k = part * 32 + i * 8 + 2 * e; const float q0 = bflo(r[e]), q1 = bfhi(r[e]);
                df += q0 * vec[768 + k] + q1 * vec[768 + k + 1]; db += q0 * vec[896 + k] + q1 * vec[896 + k + 1]; } }
        df += __shfl_xor(df, 1); df += __shfl_xor(df, 2); db += __shfl_xor(db, 1); db += __shfl_xor(db, 2);
        if (part == 0) { vec[1024 + j] = df; vec[1152 + j] = db; }
    }
    u32x4 cbr[4];
#pragma unroll
    for (int i = 0; i < 4; ++i) { const int id = tid + 512 * i, row = id >> 4, cc = id & 15; cbr[i] = *(const u32x4*)(CS + ((size_t)unit * 2 + 1) * 16384 + row * 128 + cc * 8); }
    f32x4 S[8]; zero8(S);
    wave_gemm128(S, QS + 16 * w * MP, KS, fr, fq);
    __syncthreads();
    const int j = 16 * w + fr;
    float scf, scb;
    {
        const float Mfj = vec[256 + j], Mbj = vec[384 + j], bfj = vec[512 + j], bbj = vec[640 + j], nqfj = vec[1024 + j], nqbj = vec[1152 + j], mf = vec[1280], mb = vec[1281];
        f32x4 Sb[8]; float rf = 0.f, rb = 0.f;
#pragma unroll
        for (int n = 0; n < 8; ++n) {
            const int s0 = n * 16 + 4 * fq;
            const f32x4 af4 = *(const f32x4*)(vec + s0), ab4 = *(const f32x4*)(vec + 128 + s0);
#pragma unroll
            for (int i = 0; i < 4; ++i) {
                const int s = s0 + i;
                const float wf = (s <= j) ? __expf(af4[i] - Mfj) : 0.f, wb = (s >= j) ? __expf(ab4[i] - Mbj) : 0.f;
                const float sv = S[n][i];
                S[n][i] = sv * wf; Sb[n][i] = sv * wb; rf += sv * wf; rb += sv * wb;
            }
        }
        rf += __shfl_xor(rf, 16); rf += __shfl_xor(rf, 32); rb += __shfl_xor(rb, 16); rb += __shfl_xor(rb, 32);
        const float wif = __expf(mf - Mfj), wib = __expf(mb - Mbj);
        const float nqf = wif * nqfj + rf, nqb = wib * nqbj + rb;
        const float invf = 1.f / fmaxf(fabsf(nqf), __expf(-(bfj + Mfj))), invb = 1.f / fmaxf(fabsf(nqb), __expf(-(bbj + Mbj)));
        scf = wif * invf; scb = wib * invb;
#pragma unroll
        for (int n = 0; n < 8; ++n) {
            const f32x4 P = S[n] * invf + Sb[n] * invb;
            u32x2 o; o[0] = pk2(P[0], P[1]); o[1] = pk2(P[2], P[3]);
            *(u32x2*)(KS + j * MP + (n * 16 + 4 * fq) * 2) = o;
        }
    }
    f32x4 aF[8], aI[8]; zero8(aF); zero8(aI);
    wave_gemm128(aF, QS + 16 * w * MP, CX, fr, fq);
    wave_gemm128(aI, KS + 16 * w * MP, VT, fr, fq);
    __syncthreads();
#pragma unroll
    for (int i = 0; i < 4; ++i) { const int id = tid + 512 * i, row = id >> 4, cc = id & 15; *(u32x4*)(CX + row * MP + cc * 16) = cbr[i]; }
    u32x2 xcr[8], ogr[8];
#pragma unroll
    for (int n = 0; n < 8; ++n) { const int ch = hh * 128 + n * 16 + 4 * fq;
        xcr[n] = *(const u32x2*)(XCb + (T0 + j) * 512 + ch); ogr[n] = *(const u32x2*)(ZXO + (T0 + j) * 1024 + 512 + ch); }
    if (next >= 0) issue_qk(pre, p, next, tid);
    __syncthreads();
    f32x4 aB[8]; zero8(aB);
    wave_gemm128(aB, QS + 16 * w * MP, CX, fr, fq);
    float sum = 0.f;
#pragma unroll
    for (int n = 0; n < 8; ++n) { aI[n] = aI[n] + aF[n] * scf + aB[n] * scb; sum += aI[n][0] + aI[n][1] + aI[n][2] + aI[n][3]; }
    sum += __shfl_xor(sum, 16); sum += __shfl_xor(sum, 32);
    const float mu = sum * (1.f / 128.f);
    float s2 = 0.f;
#pragma unroll
    for (int n = 0; n < 8; ++n) { const f32x4 d = aI[n] - mu; s2 += d[0] * d[0] + d[1] * d[1] + d[2] * d[2] + d[3] * d[3]; }
    s2 += __shfl_xor(s2, 16); s2 += __shfl_xor(s2, 32);
    const float rs = rsqrtf(s2 * (1.f / 128.f) + EPSN);
#pragma unroll
    for (int n = 0; n < 8; ++n) {
        const int ch = hh * 128 + n * 16 + 4 * fq;
        const f32x4 gn = *(const f32x4*)(mhn + ch), sk = *(const f32x4*)(skip + ch);
        const u32x2 xr = xcr[n], orr = ogr[n];
        const f32x4 xc = {bflo(xr[0]), bfhi(xr[0]), bflo(xr[1]), bfhi(xr[1])}, og = {bflo(orr[0]), bfhi(orr[0]), bflo(orr[1]), bfhi(orr[1])};
        f32x4 y;
#pragma unroll
        for (int i = 0; i < 4; ++i) y[i] = ((aI[n][i] - mu) * rs * gn[i] + sk[i] * xc[i]) * sigmoidf_(og[i]);
        u32x2 o; o[0] = pk2(y[0], y[1]); o[1] = pk2(y[2], y[3]);
        *(u32x2*)(ZUV + (T0 + j) * 1024 + 512 + ch) = o;
    }
    __syncthreads();
}

__device__ __forceinline__ void phase_final(const Params& p) {
    const int tid = l_tid(), lane = tid & 63, w = tid >> 6;
    const int gw = l_bid() * 8 + w, NGW = GRID * 8;
    const float* ssq = (const float*)(p.ws + WS_SSQ) + (size_t)6 * T_TOK * 16; const float* g = p.in[26];
    const bf16_t* XB = (const bf16_t*)(p.ws + WS_XB);
    f32x4 gg[4];
#pragma unroll
    for (int j = 0; j < 4; ++j) gg[j] = ((const f32x4*)g)[lane + 64 * j];
    for (int row = gw; row < T_TOK; row += NGW) {
        float s = lane < 16 ? ssq[(size_t)row * 16 + lane] : 0.f;
        s += __shfl_xor(s, 1); s += __shfl_xor(s, 2); s += __shfl_xor(s, 4); s += __shfl_xor(s, 8);
        s = __shfl(s, 0);
        const float rstd = rsqrtf(s * (1.f / DM) + EPSN);
        const u32x2* xb = (const u32x2*)(XB + (size_t)row * DM) + lane;
        f32x4* o = (f32x4*)(p.out + (size_t)row * DM) + lane;
#pragma unroll
        for (int j = 0; j < 4; ++j) { const u32x2 t = xb[64 * j]; o[64 * j] = (f32x4){bflo(t[0]), bfhi(t[0]), bflo(t[1]), bfhi(t[1])} * rstd * gg[j]; }
    }
}

__global__ __launch_bounds__(512, 2) void mega_fwd(Params p) {
    extern __shared__ __attribute__((aligned(16))) unsigned char shm[];
    cg::grid_group grid = cg::this_grid();
    float* ssq = (float*)(p.ws + WS_SSQ);
    bf16_t* XB = (bf16_t*)(p.ws + WS_XB); bf16_t* Hh = (bf16_t*)(p.ws + WS_U);
    bf16_t* ZUV = (bf16_t*)(p.ws + WS_ZUV); bf16_t* ZXO = (bf16_t*)(p.ws + WS_ZXO);
    volatile LAS unsigned* st = (volatile LAS unsigned*)((PG8_LAS unsigned char*)shm + LDS_MAIN);
    if (threadIdx.x == 0) { st[0] = 0u; st[1] = 0u; st[2] = 0u; st[3] = 0u; }
    __syncthreads();
    XcdBarrier xbar = xcd_barrier_post((unsigned*)(p.ws + WS_BAR), st);
    for (int ph = p.ph_lo; ph < p.ph_hi; ++ph) {
        if (ph >= 1 && ph <= 20 && (ph - 1) % 10 == 4) continue;
        if (ph > p.ph_lo) { if (p.ph_hi > 1000) grid.sync(); else xcd_barrier(xbar); }
        if (ph == 0) { phase_prologue(p, shm); continue; }
        if (ph == 21) { phase_final(p); continue; }
        const int l = (ph - 1) / 10, s = (ph - 1) % 10;
        const unsigned char* wl = p.ws + WS_W + (size_t)l * LW_END;
        const float* ss_a = ssq + (size_t)(3 * l) * T_TOK * 16;
        float* ss_b = ssq + (size_t)(3 * l + 1) * T_TOK * 16;
        float* ss_c = ssq + (size_t)(3 * l + 2) * T_TOK * 16;
        float* ss_d = ssq + (size_t)(3 * l + 3) * T_TOK * 16;
        switch (s) {
        case 0: { EpiUp E{Hh, nullptr, 0}; run_gemm_rs(shm, XB, (const bf16_t*)(wl + LW_GU1), 2 * FF, DM, E, ss_a); } break;
        case 1: { EpiRes<false> E{nullptr, XB, ss_b, 0.5f}; run_gemm(shm, Hh, (const bf16_t*)(wl + LW_D1), DM, FF, E); } break;
        case 2: { EpiWin E{ZUV, ZXO, nullptr, 0}; run_gemm_rs(shm, XB, (const bf16_t*)(wl + LW_IN), 2048, DM, E, ss_b); } break;
        case 3: phase_prep(p, l, shm); asm volatile("s_waitcnt vmcnt(0)" ::: "memory"); __syncthreads(); phase_state(p, shm); break;
        case 4: break;
        case 5: phase_scan_sgu(p, l, shm); break;
        case 6: { QKPre pre; int k = l_bid(); issue_qk(pre, p, k, l_tid());
                  for (; k < 1024; k += GRID) unit_out(p, l, shm, k, pre, k + GRID < 1024 ? k + GRID : -1); } break;
        case 7: { EpiRes<false> E{nullptr, XB, ss_c, 1.0f}; run_gemm(shm, ZUV, (const bf16_t*)(wl + LW_OUT), DM, DM, E); } break;
        case 8: { EpiUp E{Hh, nullptr, 0}; run_gemm_rs(shm, XB, (const bf16_t*)(wl + LW_GU2), 2 * FF, DM, E, ss_c); } break;
        case 9: { EpiRes<false> E{nullptr, XB, ss_d, 0.5f}; run_gemm(shm, Hh, (const bf16_t*)(wl + LW_D2), DM, FF, E); } break;
        }
    }
}

#ifndef ONE_LAUNCH
#define ONE_LAUNCH 1
#endif
extern "C" void kernel_launch(void* const* d_in, const int* in_sizes, int n_in, void* d_out, int out_size, void* d_ws, size_t ws_size, hipStream_t stream) {
    static int grid = 0;
    if (grid == 0) {
        if (n_in != 27 || ws_size < WS_END) { fprintf(stderr, "kernel_launch: unexpected n_in %d or ws_size %zu (need %zu)\n", n_in, ws_size, (size_t)WS_END); grid = -1; return; }
        int dev = 0, cus = 0, per_cu = 0;
        hipGetDevice(&dev);
        hipDeviceGetAttribute(&cus, hipDeviceAttributeMultiprocessorCount, dev);
        if (hipFuncSetAttribute((const void*)mega_fwd, hipFuncAttributeMaxDynamicSharedMemorySize, LDS_BYTES) != hipSuccess) { fprintf(stderr, "kernel_launch: hipFuncSetAttribute failed\n"); grid = -1; return; }
        if (hipOccupancyMaxActiveBlocksPerMultiprocessor(&per_cu, (const void*)mega_fwd, 512, LDS_BYTES) != hipSuccess || per_cu < 1) { fprintf(stderr, "kernel_launch: occupancy query says %d\n", per_cu); per_cu = 1; }
        (void)hipGetLastError();
        grid = cus * per_cu;
        if (grid < GRID) { fprintf(stderr, "kernel_launch: this build needs %d co-resident workgroups, device offers %d\n", GRID, grid); grid = -1; return; }
        grid = GRID;
    }
    if (grid < 0) return;
    (void)hipMemsetAsync((unsigned char*)d_ws + WS_BAR, 0, (size_t)XCD_BAR_WORDS * 4, stream);
    Params p{};
    for (int i = 0; i < 27; ++i) p.in[i] = (const float*)d_in[i];
    p.out = (float*)d_out; p.ws = (unsigned char*)d_ws;
#if ONE_LAUNCH
    p.ph_lo = 0; p.ph_hi = 22;
    void* args[] = {&p};
    hipError_t e = hipLaunchCooperativeKernel((const void*)mega_fwd, dim3(grid), dim3(512), args, LDS_BYTES, stream);
    if (e != hipSuccess) fprintf(stderr, "cooperative launch failed: %s (grid %d)\n", hipGetErrorString(e), grid);
#else
    for (int ph = 0; ph < 22; ++ph) { p.ph_lo = ph; p.ph_hi = ph + 1; hipLaunchKernelGGL(mega_fwd, dim3(grid), dim3(512), LDS_BYTES, stream, p); }
#endif
}
```

```cpp
#include <hip/hip_runtime.h>
#include <hip/hip_cooperative_groups.h>
#include <cstdio>
namespace cg = cooperative_groups;
#ifndef GEMM_SP2
#define GEMM_SP2 true
#endif
#ifndef GEMM_ALIGN
#define GEMM_ALIGN true
#endif
constexpr int GRID = 256;

typedef unsigned short bf16_t;
typedef short bf16x8 __attribute__((ext_vector_type(8)));
typedef float f32x4 __attribute__((ext_vector_type(4)));
typedef unsigned u32x4 __attribute__((ext_vector_type(4)));
typedef unsigned u32x2 __attribute__((ext_vector_type(2)));

__device__ __forceinline__ int l_tid() { int t = threadIdx.x; asm volatile("" : "+v"(t)); return t; }
__device__ __forceinline__ int l_bid() { int t = blockIdx.x; asm volatile("" : "+s"(t)); return t; }

namespace pg8 {
#define PG8_LAS __attribute__((address_space(3)))
constexpr int BM = 256, BK = 64, HALF = 128, HTB = HALF * BK * 2  , STAGE_BYTES = 8 * HTB, NXCD = 8, WGM = 8;

__host__ __device__ __forceinline__ int lds_byte(int r, int c) { const int st = (r >> 4) * 2 + (c >> 5), rr = r & 15, cc = c & 31, ob = rr * 64 + cc * 2; return st * 1024 + (ob ^ (((ob >> 9) & 1) << 5)); }
__host__ __device__ __forceinline__ void stage_rc(int b, int& R, int& C) { const int st = b / 1024, sb = b % 1024, swz = sb ^ (((sb >> 9) & 1) << 5); R = (st >> 1) * 16 + swz / 64; C = (st & 1) * 32 + (swz % 64) / 2; }
__host__ __device__ __forceinline__ int perm32(int rho) { const int n = rho >> 4, i = rho & 15; return 8 * (i >> 2) + 4 * n + (i & 3); }

struct Unit { int pm, pn; };
struct Gemm { const bf16_t* A; const bf16_t* Bt; int M, N, K; };

struct StaticOrder {
    int nM, nN, nwg, G, c;
    __host__ __device__ void init(int M, int N, int G_, int c_) { nM = M / BM; nN = N / BM; nwg = nM * nN; G = G_; c = c_; }
    __host__ __device__ bool next(int i, Unit& u) const {
        const long L = (long)i * G + c; if (L >= nwg) return false;
        int wgid = (int)L; { const int q = nwg / NXCD, r = nwg % NXCD, xcd = wgid % NXCD, off = wgid / NXCD; wgid = (xcd < r ? xcd * (q + 1) : r * (q + 1) + (xcd - r) * q) + off; }
        const int nig = WGM * nN, gid = wgid / nig, fm = gid * WGM, gsz = (nM - fm) < WGM ? (nM - fm) : WGM;
        u.pm = fm + ((wgid % nig) % gsz); u.pn = (wgid % nig) / gsz; return true;
    }
    __device__ __forceinline__ void a_ready(const Unit&) const {}
    __device__ __forceinline__ void done(const Unit&) const {}
};

template <class Epi, class Sched, bool ALIGN_EPI = false, bool SP2 = false>
__device__ __forceinline__ void gemm_phase(PG8_LAS unsigned char* lds, const Gemm g, const Sched& S, const Epi& E) {
    const int tid = l_tid(), wid = __builtin_amdgcn_readfirstlane(tid >> 6), lane = tid & 63, wr = wid >> 2, wc = wid & 3, fr = lane & 15, fq = lane >> 4;
    const int K = g.K, nt = K / BK;
    unsigned voffA[2], voffB[2];
#pragma unroll
    for (int i = 0; i < 2; ++i) { int R, C; stage_rc(tid * 16 + i * 8192, R, C); const int Rb = Epi::PERM ? ((R & ~31) + perm32(R & 31)) : R;
        voffA[i] = (unsigned)(R * K + C) * 2u; voffB[i] = (unsigned)(Rb * K + C) * 2u; }
    const size_t kstep = (size_t)(BK * 2);
    const size_t hstep = (size_t)HALF * K * 2;
    const size_t tstep = 2 * hstep;
    const unsigned ldsw = (unsigned)wid * 1024u;
    const int aoff = lds_byte(wr * 64 + fr, fq * 8), boff = lds_byte(wc * 32 + fr, fq * 8);
#define PG8_SA(b, h) (((b) * 2 + (h)) * HTB)
#define PG8_SB(b, h) ((4 + (b) * 2 + (h)) * HTB)
#define PG8_STAGE(bufoff, gbase, voff) do { _Pragma("unroll") for (int _i = 0; _i < 2; ++_i) \
        __builtin_amdgcn_global_load_lds((const unsigned*)((const char*)(gbase) + (voff)[_i]), (PG8_LAS unsigned*)(lds + (bufoff) + ldsw + _i * 8192), 16, 0, 0); } while (0)
#define PG8_LDA(dst, b, h) do { _Pragma("unroll") for (int m = 0; m < 4; ++m) _Pragma("unroll") for (int k = 0; k < 2; ++k) dst[m][k] = *(const PG8_LAS bf16x8*)(lds + PG8_SA(b, h) + aoff + m * 2048 + k * 1024); } while (0)
#define PG8_LDB(dst, b, h) do { _Pragma("unroll") for (int n = 0; n < 2; ++n) _Pragma("unroll") for (int k = 0; k < 2; ++k) dst[n][k] = *(const PG8_LAS bf16x8*)(lds + PG8_SB(b, h) + boff + n * 2048 + k * 1024); } while (0)
#define PG8_MMA(ai, bj, At, Bt) do { __builtin_amdgcn_s_setprio(1); _Pragma("unroll") for (int m = 0; m < 4; ++m) _Pragma("unroll") for (int n = 0; n < 2; ++n) _Pragma("unroll") for (int k = 0; k < 2; ++k) \
        acc[ai][bj][m][n] = __builtin_amdgcn_mfma_f32_16x16x32_bf16(Bt[n][k], At[m][k], acc[ai][bj][m][n], 0, 0, 0); __builtin_amdgcn_s_setprio(0); } while (0)
#define PG8_WAIT_V(n) asm volatile("s_waitcnt vmcnt(" #n ")" ::: "memory")
#define PG8_WAIT_L(n) asm volatile("s_waitcnt lgkmcnt(" #n ")" ::: "memory")
#define PG8_BAR __builtin_amdgcn_s_barrier()
#define PG8_SCHED __builtin_amdgcn_sched_barrier(0)
    Unit cur, nxt; int ui = 0;
    if (!S.next(0, cur)) return;
    f32x4 acc[2][2][4][2];
#pragma unroll
    for (int a = 0; a < 2; ++a)
#pragma unroll
        for (int b = 0; b < 2; ++b)
#pragma unroll
            for (int m = 0; m < 4; ++m)
#pragma unroll
                for (int n = 0; n < 2; ++n) acc[a][b][m][n] = (f32x4){0.f, 0.f, 0.f, 0.f};
    bf16x8 At[4][2], B0[2][2], B1[2][2];
    const char* cA = (const char*)g.A + (size_t)cur.pm * tstep; const char* cB = (const char*)g.Bt + (size_t)cur.pn * tstep;
    S.a_ready(cur);
    if constexpr (SP2) {
        PG8_STAGE(PG8_SB(0, 0), cB, voffB); PG8_STAGE(PG8_SB(0, 1), cB + hstep, voffB); PG8_STAGE(PG8_SA(0, 0), cA, voffA); PG8_STAGE(PG8_SA(0, 1), cA + hstep, voffA);
        if (wr == 1) PG8_BAR;
        PG8_WAIT_V(2); PG8_BAR;
        PG8_STAGE(PG8_SB(1, 0), cB + kstep, voffB); PG8_STAGE(PG8_SA(1, 0), cA + kstep, voffA); PG8_STAGE(PG8_SB(1, 1), cB + hstep + kstep, voffB);
        PG8_WAIT_V(6); PG8_BAR;
    } else {
        PG8_STAGE(PG8_SB(0, 0), cB, voffB); PG8_STAGE(PG8_SA(0, 0), cA, voffA); PG8_STAGE(PG8_SB(0, 1), cB + hstep, voffB); PG8_STAGE(PG8_SA(0, 1), cA + hstep, voffA);
        if (wr == 1) PG8_BAR;
        PG8_WAIT_V(4); PG8_BAR;
        PG8_STAGE(PG8_SB(1, 0), cB + kstep, voffB); PG8_STAGE(PG8_SA(1, 0), cA + kstep, voffA); PG8_STAGE(PG8_SB(1, 1), cB + hstep + kstep, voffB);
        PG8_WAIT_V(6); PG8_BAR;
    }
    for (;;) {
        const bool has_next = S.next(ui + 1, nxt);
        const char* nA = has_next ? (const char*)g.A + (size_t)nxt.pm * tstep : cA; const char* nB = has_next ? (const char*)g.Bt + (size_t)nxt.pn * tstep : cB;
        for (int t = 0; t < nt; t += 2) {
            const bool last = (t == nt - 2);
            const char* a1 = cA + (size_t)(t + 1) * kstep;
            const char* a2 = last ? nA : cA + (size_t)(t + 2) * kstep; const char* b2 = last ? nB : cB + (size_t)(t + 2) * kstep;
            const char* a3 = a2 + kstep; const char* b3 = b2 + kstep;
            if (last && has_next) S.a_ready(nxt);
            if constexpr (SP2) {
            PG8_LDB(B0, 0, 0); PG8_LDB(B1, 0, 1); PG8_SCHED; PG8_LDA(At, 0, 0); PG8_STAGE(PG8_SA(1, 1), a1 + hstep, voffA);
            PG8_WAIT_V(8); PG8_WAIT_L(0); PG8_BAR; PG8_MMA(0, 0, At, B0); PG8_MMA(0, 1, At, B1); PG8_BAR; PG8_SCHED;
            PG8_LDA(At, 0, 1); PG8_STAGE(PG8_SB(0, 0), b2, voffB); PG8_STAGE(PG8_SB(0, 1), b2 + hstep, voffB); PG8_STAGE(PG8_SA(0, 0), a2, voffA);
            PG8_WAIT_V(8); PG8_WAIT_L(0); PG8_BAR; PG8_MMA(1, 0, At, B0); PG8_MMA(1, 1, At, B1); PG8_BAR; PG8_SCHED;
            PG8_LDB(B0, 1, 0); PG8_LDB(B1, 1, 1); PG8_SCHED; PG8_LDA(At, 1, 0); PG8_STAGE(PG8_SA(0, 1), a2 + hstep, voffA);
            PG8_WAIT_V(8); PG8_WAIT_L(0); PG8_BAR; PG8_MMA(0, 0, At, B0); PG8_MMA(0, 1, At, B1); PG8_BAR; PG8_SCHED;
            PG8_LDA(At, 1, 1); PG8_STAGE(PG8_SB(1, 0), b3, voffB); PG8_STAGE(PG8_SB(1, 1), b3 + hstep, voffB); PG8_STAGE(PG8_SA(1, 0), a3, voffA);
            PG8_WAIT_V(8); PG8_WAIT_L(0); PG8_BAR; PG8_MMA(1, 0, At, B0); PG8_MMA(1, 1, At, B1); PG8_BAR; PG8_SCHED;
            } else {
            PG8_LDB(B0, 0, 0); PG8_SCHED; PG8_LDA(At, 0, 0); PG8_STAGE(PG8_SA(1, 1), a1 + hstep, voffA);
            PG8_WAIT_L(8); PG8_BAR; PG8_WAIT_L(0); PG8_MMA(0, 0, At, B0); PG8_BAR; PG8_SCHED;
            PG8_LDB(B1, 0, 1); PG8_STAGE(PG8_SB(0, 0), b2, voffB);
            PG8_BAR; PG8_WAIT_L(0); PG8_MMA(0, 1, At, B1); PG8_BAR;
            PG8_LDA(At, 0, 1); PG8_STAGE(PG8_SA(0, 0), a2, voffA);
            PG8_BAR; PG8_WAIT_L(0); PG8_MMA(1, 0, At, B0); PG8_BAR; PG8_SCHED;
            PG8_STAGE(PG8_SB(0, 1), b2 + hstep, voffB);
            PG8_WAIT_V(6); PG8_BAR; PG8_MMA(1, 1, At, B1); PG8_BAR;
            PG8_LDB(B0, 1, 0); PG8_SCHED; PG8_LDA(At, 1, 0); PG8_STAGE(PG8_SA(0, 1), a2 + hstep, voffA);
            PG8_WAIT_L(8); PG8_BAR; PG8_WAIT_L(0); PG8_MMA(0, 0, At, B0); PG8_BAR; PG8_SCHED;
            PG8_LDB(B1, 1, 1); PG8_STAGE(PG8_SB(1, 0), b3, voffB);
            PG8_BAR; PG8_WAIT_L(0); PG8_MMA(0, 1, At, B1); PG8_BAR;
            PG8_LDA(At, 1, 1); PG8_STAGE(PG8_SA(1, 0), a3, voffA);
            PG8_BAR; PG8_WAIT_L(0); PG8_MMA(1, 0, At, B0); PG8_BAR; PG8_SCHED;
            PG8_STAGE(PG8_SB(1, 1), b3 + hstep, voffB);
            PG8_WAIT_V(6); PG8_BAR; PG8_MMA(1, 1, At, B1); PG8_BAR;
            }
        }
        if constexpr (ALIGN_EPI) { if (wr == 0) PG8_BAR; }
        if constexpr (!Epi::AFTER_DRAIN) { E(acc, cur, wr, wc, fr, fq); S.done(cur); }
        if (!has_next) break;
#pragma unroll
        for (int a = 0; a < 2; ++a)
#pragma unroll
            for (int b = 0; b < 2; ++b)
#pragma unroll
                for (int m = 0; m < 4; ++m)
#pragma unroll
                    for (int n = 0; n < 2; ++n) acc[a][b][m][n] = (f32x4){0.f, 0.f, 0.f, 0.f};
        cur = nxt; cA = nA; cB = nB; ++ui;
        if constexpr (ALIGN_EPI) { if (wr == 1) PG8_BAR; }
    }
    PG8_WAIT_V(0);
    if constexpr (!ALIGN_EPI) { if (wr == 0) PG8_BAR; }
    PG8_BAR;
    if constexpr (Epi::AFTER_DRAIN) { E.fused(acc, cur, wr, wc, fr, fq, lds, wid, lane); S.done(cur); }
#undef PG8_SA
#undef PG8_SB
#undef PG8_STAGE
#undef PG8_LDA
#undef PG8_LDB
#undef PG8_MMA
#undef PG8_WAIT_V
#undef PG8_WAIT_L
#undef PG8_BAR
#undef PG8_SCHED
}
}

#define XB_TMO      128
#define XB_XCNT(j)  (256  + 64 * (j))
#define XB_XSUB(j)  (1280 + 64 * (j))
#define XB_XGEN(j)  (2304 + 64 * (j))
#define XB_TOP      3328
#define XB_TOPGEN   3392
#define XCD_BAR_WORDS 3456
#define XB_SPIN_CAP (1u << 18)
#define LAS __attribute__((address_space(3)))

__device__ __forceinline__ unsigned xb_ld(unsigned* p)              { return __hip_atomic_load(p, __ATOMIC_RELAXED, __HIP_MEMORY_SCOPE_AGENT); }
__device__ __forceinline__ unsigned xb_add(unsigned* p, unsigned v) { return __hip_atomic_fetch_add(p, v, __ATOMIC_RELAXED, __HIP_MEMORY_SCOPE_AGENT); }
__device__ __forceinline__ unsigned xb_xcc_id() { return (unsigned)__builtin_amdgcn_s_getreg((3 << 11) | 20) & 0xFu; }
#define XB_SPIN(cond, bar) do { unsigned _sp = 0; while (cond) { __builtin_amdgcn_s_sleep(1); \
    if ((++_sp & 255u) == 0u) { if (xb_ld(&(bar)[XB_TMO])) break; if (_sp > XB_SPIN_CAP) { atomicAdd(&(bar)[XB_TMO], 1u); break; } } } } while (0)

struct XcdBarrier {
    unsigned* bar; unsigned x;
    volatile LAS unsigned* st;
};

__device__ __forceinline__ XcdBarrier xcd_barrier_post(unsigned* bar, volatile LAS unsigned* st) {
    XcdBarrier b; b.bar = bar; b.x = xb_xcc_id(); b.st = st;
    if (threadIdx.x == 0) (void)xb_add(&bar[XB_XCNT(b.x)], 1u);
    return b;
}
__device__ __forceinline__ void xcd_barrier_complete(unsigned* bar, unsigned x, unsigned& nloc, unsigned& nx) {
    const unsigned G = GRID;
    unsigned sum, cnt, mine, sp = 0u;
    for (;;) {
        sum = 0u; cnt = 0u; mine = 0u;
#pragma unroll
        for (unsigned j = 0; j < 16; ++j) { const unsigned c = xb_ld(&bar[XB_XCNT(j)]); sum += c; cnt += (c > 0u) ? 1u : 0u; mine = (j == x) ? c : mine; }
        if (sum == G) break;
        __builtin_amdgcn_s_sleep(1);
        if ((++sp & 255u) == 0u) { if (xb_ld(&bar[XB_TMO])) break; if (sp > XB_SPIN_CAP) { atomicAdd(&bar[XB_TMO], 1u); break; } }
    }
    nloc = mine > 0u ? mine : 1u; nx = cnt > 0u ? cnt : 1u;
}

__device__ __forceinline__ void xcd_barrier(const XcdBarrier& b) {
    asm volatile("s_waitcnt vmcnt(0)" ::: "memory");
    __syncthreads();
    if (threadIdx.x == 0) {
        unsigned* bar = b.bar;
        __builtin_amdgcn_s_waitcnt(0);
        unsigned nloc = b.st[0], nx = b.st[1];
        if (nloc == 0u) { xcd_barrier_complete(bar, b.x, nloc, nx); b.st[0] = nloc; b.st[1] = nx; }
        const unsigned old = xb_add(&bar[XB_XSUB(b.x)], 1u);
        const unsigned gen = old / nloc;
        if (old + 1u == (gen + 1u) * nloc) {
            __builtin_amdgcn_fence(__ATOMIC_RELEASE, "agent");
            asm volatile("s_waitcnt vmcnt(0)" ::: "memory");
            const unsigned og = xb_add(&bar[XB_TOP], 1u);
            const unsigned tg = og / nx;
            if (og + 1u == (tg + 1u) * nx) xb_add(&bar[XB_TOPGEN], 1u);
            else XB_SPIN(xb_ld(&bar[XB_TOPGEN]) == tg, bar);
            __builtin_amdgcn_fence(__ATOMIC_ACQUIRE, "agent");
            xb_add(&bar[XB_XGEN(b.x)], 1u);
            asm volatile("s_waitcnt vmcnt(0)" ::: "memory");
        } else {
            XB_SPIN(xb_ld(&bar[XB_XGEN(b.x)]) == gen, bar);
            __builtin_amdgcn_fence(__ATOMIC_ACQUIRE, "agent");
            asm volatile("s_waitcnt vmcnt(0)" ::: "memory");
        }
    }
    __syncthreads();
}


constexpr int T_TOK = 32768, DM = 1024, FF = 2816, SEQ = 8192, NCH = 64;
constexpr float EPSN = 1e-6f;
constexpr int MP = 272;
constexpr int MBUF = 128 * MP;
constexpr int LDS_MAIN = 157952;
static_assert(LDS_MAIN >= 4 * MBUF + 8192 && LDS_MAIN % 16 == 0, "LDS map");
constexpr int LDS_BYTES = LDS_MAIN + 16;

constexpr size_t SZ_WGU = (size_t)2 * FF * DM * 2, SZ_WD = (size_t)DM * FF * 2, SZ_WIN = (size_t)2048 * DM * 2, SZ_WOUT = (size_t)DM * DM * 2;
constexpr size_t SZ_SGUW = (size_t)4 * 128 * 128 * 2, SZ_WGT = (size_t)16 * 1536 * 2;
constexpr size_t LW_GU1 = 0, LW_D1 = LW_GU1 + SZ_WGU, LW_IN = LW_D1 + SZ_WD, LW_OUT = LW_IN + SZ_WIN, LW_GU2 = LW_OUT + SZ_WOUT, LW_D2 = LW_GU2 + SZ_WGU,
                 LW_SGU = LW_D2 + SZ_WD, LW_GT = LW_SGU + SZ_SGUW, LW_END = LW_GT + SZ_WGT;
constexpr size_t WS_W = 0;
constexpr size_t WS_XB = WS_W + 2 * LW_END;
constexpr size_t WS_U = WS_XB + (size_t)T_TOK * DM * 2;
constexpr size_t WS_ZUV = WS_U, WS_ZXO = WS_ZUV + (size_t)T_TOK * 1024 * 2, WS_Q = WS_ZXO + (size_t)T_TOK * 1024 * 2,
                 WS_K = WS_Q + (size_t)T_TOK * 512 * 2, WS_V = WS_K + (size_t)T_TOK * 512 * 2, WS_XC = WS_V + (size_t)T_TOK * 512 * 2,
                 WS_UEND = WS_XC + (size_t)T_TOK * 512 * 2;
static_assert(WS_UEND - WS_U >= (size_t)T_TOK * FF * 2, "H must fit the shared region");
constexpr size_t WS_SSQ = WS_UEND;
constexpr size_t WS_BV = WS_SSQ + (size_t)7 * T_TOK * 16 * 4, WS_AV = WS_BV + (size_t)2048 * 128 * 4, WS_CM = WS_AV + (size_t)2048 * 128 * 4,
                 WS_DN = WS_CM + (size_t)2048 * 128 * 4, WS_SC = WS_DN + (size_t)2048 * 128 * 4, WS_MS = WS_SC + (size_t)2048 * 2 * 4,
                 WS_BAR = WS_MS + (size_t)2048 * 4, WS_CS = (WS_BAR + (size_t)XCD_BAR_WORDS * 4 + 255) / 256 * 256,
                 WS_END = WS_CS + (size_t)2048 * 16384 * 2;

struct Params {
    const float* in[27];
    float* out;
    unsigned char* ws;
    int ph_lo, ph_hi;
};

typedef __bf16 bf16x2_t __attribute__((ext_vector_type(2)));
typedef float f32x2_t __attribute__((ext_vector_type(2)));
__device__ __forceinline__ unsigned pk2(float lo, float hi) { const f32x2_t v = {lo, hi}; const bf16x2_t b = __builtin_convertvector(v, bf16x2_t); return __builtin_bit_cast(unsigned, b); }
__device__ __forceinline__ float bflo(unsigned w) { return __uint_as_float(w << 16); }
__device__ __forceinline__ float bfhi(unsigned w) { return __uint_as_float(w & 0xffff0000u); }
__device__ __forceinline__ float bfel(const u32x4& v, int e) { const unsigned w = v[e >> 1]; return (e & 1) ? bfhi(w) : bflo(w); }
__device__ __forceinline__ float sigmoidf_(float x) { return __builtin_amdgcn_rcpf(1.f + __expf(-x)); }
__device__ __forceinline__ float gelu_tanh(float x) { const float y = 0.7978845608028654f * (x + 0.044715f * x * x * x); return x * __builtin_amdgcn_rcpf(1.f + __expf(-2.f * y)); }
__device__ __forceinline__ float logsig(float x) { return fminf(x, 0.f) - log1pf(expf(-fabsf(x))); }
__device__ __forceinline__ float wave_sum(float v) {
#pragma unroll
    for (int o = 1; o < 64; o <<= 1) v += __shfl_xor(v, o);
    return v;
}

__device__ __forceinline__ float row_ssq(const float* part, int row) {
    const f32x4* q = (const f32x4*)(part + (size_t)row * 16);
    const f32x4 a = q[0], b = q[1], c = q[2], d = q[3];
    return (((a[0] + a[1]) + (a[2] + a[3])) + ((b[0] + b[1]) + (b[2] + b[3]))) + (((c[0] + c[1]) + (c[2] + c[3])) + ((d[0] + d[1]) + (d[2] + d[3])));
}
__device__ __forceinline__ void wave_gemm128(f32x4 (&acc)[8], const unsigned char* Arows, const unsigned char* Brows, int fr, int fq) {
#pragma unroll
    for (int kk = 0; kk < 4; ++kk) {
        const bf16x8 a = *(const bf16x8*)(Arows + fr * MP + kk * 64 + fq * 16);
#pragma unroll
        for (int n = 0; n < 8; ++n) {
            const bf16x8 b = *(const bf16x8*)(Brows + (n * 16 + fr) * MP + kk * 64 + fq * 16);
            acc[n] = __builtin_amdgcn_mfma_f32_16x16x32_bf16(b, a, acc[n], 0, 0, 0);
        }
    }
}
__device__ __forceinline__ void zero8(f32x4 (&acc)[8]) {
#pragma unroll
    for (int n = 0; n < 8; ++n) acc[n] = (f32x4){0.f, 0.f, 0.f, 0.f};
}
__device__ __forceinline__ void load_tile(unsigned char* dst, const bf16_t* src, size_t gp, int tid) {
#pragma unroll
    for (int i = 0; i < 4; ++i) { const int id = tid + 512 * i, row = id >> 4, cc = id & 15;
        *(u32x4*)(dst + row * MP + cc * 16) = *(const u32x4*)(src + (size_t)row * gp + cc * 8); }
}

struct EpiUp {
    static constexpr bool PERM = true, AFTER_DRAIN = false;
    bf16_t* H; const PG8_LAS float* rs; int pm0;
    __device__ __forceinline__ void operator()(const f32x4 (&acc)[2][2][4][2], const pg8::Unit& u, int wr, int wc, int fr, int fq) const {
        const int row0 = u.pm * 256 + wr * 64 + fr, col = u.pn * 128 + wc * 32 + 8 * fq;
#pragma unroll
        for (int ai = 0; ai < 2; ++ai)
#pragma unroll
            for (int m = 0; m < 4; ++m) {
                const int row = row0 + ai * 128 + m * 16;
                const float rstd = rs[((u.pm - pm0) >> 3) * 256 + (row & 255)];
                float h[8];
#pragma unroll
                for (int n = 0; n < 2; ++n)
#pragma unroll
                    for (int i = 0; i < 4; ++i) { const float g = acc[ai][0][m][n][i] * rstd, uu = acc[ai][1][m][n][i] * rstd; h[4 * n + i] = g * uu * __builtin_amdgcn_rcpf(1.f + __expf(-g)); }
                u32x4 o; o[0] = pk2(h[0], h[1]); o[1] = pk2(h[2], h[3]); o[2] = pk2(h[4], h[5]); o[3] = pk2(h[6], h[7]);
                *(u32x4*)(H + (size_t)row * FF + col) = o;
            }
    }
};
template <bool RIN_F32> struct EpiRes {
    static constexpr bool PERM = true, AFTER_DRAIN = false;
    const float* Rin; bf16_t* XB; float* ssq; float scale;
    __device__ __forceinline__ void operator()(const f32x4 (&acc)[2][2][4][2], const pg8::Unit& u, int wr, int wc, int fr, int fq) const {
        static_assert(!RIN_F32, "the residual stream is bf16");
        const int row0 = u.pm * 256 + wr * 64 + fr, col0 = u.pn * 256 + wc * 32 + 8 * fq;
        u32x4 rb[4][2], ob[4][2];
#pragma unroll
        for (int m = 0; m < 4; ++m)
#pragma unroll
            for (int bj = 0; bj < 2; ++bj) rb[m][bj] = *(const u32x4*)(XB + (size_t)(row0 + m * 16) * DM + col0 + bj * 128);
#pragma unroll
        for (int ai = 0; ai < 2; ++ai) {
            float ssv[4];
#pragma unroll
            for (int m = 0; m < 4; ++m) {
                float ss = 0.f;
#pragma unroll
                for (int bj = 0; bj < 2; ++bj) {
                    const u32x4 t = rb[m][bj];
                    const f32x4 r0 = {bflo(t[0]), bfhi(t[0]), bflo(t[1]), bfhi(t[1])}, r1 = {bflo(t[2]), bfhi(t[2]), bflo(t[3]), bfhi(t[3])};
                    const f32x4 v0 = r0 + acc[ai][bj][m][0] * scale, v1 = r1 + acc[ai][bj][m][1] * scale;
                    u32x4 o; o[0] = pk2(v0[0], v0[1]); o[1] = pk2(v0[2], v0[3]); o[2] = pk2(v1[0], v1[1]); o[3] = pk2(v1[2], v1[3]);
                    ob[m][bj] = o;
                    ss += v0[0] * v0[0] + v0[1] * v0[1] + v0[2] * v0[2] + v0[3] * v0[3] + v1[0] * v1[0] + v1[1] * v1[1] + v1[2] * v1[2] + v1[3] * v1[3];
                }
                ss += __shfl_xor(ss, 16); ss += __shfl_xor(ss, 32);
                ssv[m] = ss;
            }
            if (ai == 0) {
#pragma unroll
                for (int m = 0; m < 4; ++m)
#pragma unroll
                    for (int bj = 0; bj < 2; ++bj) rb[m][bj] = *(const u32x4*)(XB + (size_t)(row0 + 128 + m * 16) * DM + col0 + bj * 128);
            }
#pragma unroll
            for (int m = 0; m < 4; ++m) {
                const int row = row0 + ai * 128 + m * 16;
#pragma unroll
                for (int bj = 0; bj < 2; ++bj) *(u32x4*)(XB + (size_t)row * DM + col0 + bj * 128) = ob[m][bj];
                if (fq == 0) ssq[(size_t)row * 16 + u.pn * 4 + wc] = ssv[m];
            }
        }
    }
};
struct EpiWin {
    static constexpr bool PERM = true, AFTER_DRAIN = false;
    bf16_t* ZUV; bf16_t* ZXO; const PG8_LAS float* rs; int pm0;
    __device__ __forceinline__ void operator()(const f32x4 (&acc)[2][2][4][2], const pg8::Unit& u, int wr, int wc, int fr, int fq) const {
        const bool act = u.pn < 4; bf16_t* dst = act ? ZUV : ZXO;
        const int row0 = u.pm * 256 + wr * 64 + fr, col0 = (u.pn & 3) * 256 + wc * 32 + 8 * fq;
#pragma unroll
        for (int ai = 0; ai < 2; ++ai)
#pragma unroll
            for (int m = 0; m < 4; ++m) {
                const int row = row0 + ai * 128 + m * 16;
                const float rstd = rs[((u.pm - pm0) >> 3) * 256 + (row & 255)];
#pragma unroll
                for (int bj = 0; bj < 2; ++bj) {
                    float h[8];
#pragma unroll
                    for (int n = 0; n < 2; ++n)
#pragma unroll
                        for (int i = 0; i < 4; ++i) { const float z = acc[ai][bj][m][n][i] * rstd; h[4 * n + i] = act ? gelu_tanh(z) : z; }
                    u32x4 o; o[0] = pk2(h[0], h[1]); o[1] = pk2(h[2], h[3]); o[2] = pk2(h[4], h[5]); o[3] = pk2(h[6], h[7]);
                    *(u32x4*)(dst + (size_t)row * 1024 + col0 + bj * 128) = o;
                }
            }
    }
};

template <class Epi>
__device__ __forceinline__ void run_gemm(unsigned char* shm, const bf16_t* A, const bf16_t* Bt, int N, int K, const Epi& E) {
    pg8::Gemm g{A, Bt, T_TOK, N, K};
    pg8::StaticOrder S; S.init(T_TOK, N, GRID, l_bid());
    pg8::gemm_phase<Epi, pg8::StaticOrder, GEMM_ALIGN, GEMM_SP2>((PG8_LAS unsigned char*)shm, g, S, E);
}

template <class Epi>
__device__ __forceinline__ void run_gemm_rs(unsigned char* shm, const bf16_t* A, const bf16_t* Bt, int N, int K, Epi& E, const float* ssq_part) {
    pg8::Gemm g{A, Bt, T_TOK, N, K};
    pg8::StaticOrder S; S.init(T_TOK, N, GRID, l_bid());
    pg8::Unit u0; if (!S.next(0, u0)) return;
    PG8_LAS float* rl = (PG8_LAS float*)(PG8_LAS unsigned char*)shm + 131072 / 4;
    const int tid = l_tid();
    for (int i = tid; i < 1024; i += 512) { const int pm = u0.pm + 8 * (i >> 8);
        if (pm < T_TOK / 256) rl[i] = rsqrtf(row_ssq(ssq_part, pm * 256 + (i & 255)) * (1.f / DM) + EPSN); }
    __syncthreads();
    E.rs = rl; E.pm0 = u0.pm;
    pg8::gemm_phase<Epi, pg8::StaticOrder, GEMM_ALIGN, GEMM_SP2>((PG8_LAS unsigned char*)shm, g, S, E);
}

__device__ __forceinline__ void transpose_item(const float* W, int K, int N, bf16_t* WT, const float* gain, int mode, float* scr, int item, int lane) {
    const int nblk = N / 64, kb = item / nblk, nb = item % nblk, k0 = 64 * kb, n0 = 64 * nb;
    const int r = lane >> 4, c4 = lane & 15;
#pragma unroll 8
    for (int i = 0; i < 16; ++i) { const int kk = 4 * i + r; f32x4 v = *(const f32x4*)(W + (size_t)(k0 + kk) * N + n0 + 4 * c4);
        if (gain) v = v * gain[k0 + kk];
        float* d = scr + kk * 65 + 4 * c4; d[0] = v[0]; d[1] = v[1]; d[2] = v[2]; d[3] = v[3]; }
    asm volatile("s_waitcnt lgkmcnt(0)" ::: "memory");
    const int c = lane & 7, nl = lane >> 3;
#pragma unroll
    for (int j = 0; j < 8; ++j) { const int n = nl + 8 * j; const float* q = scr + (8 * c) * 65 + n;
        u32x4 o; o[0] = pk2(q[0 * 65], q[1 * 65]); o[1] = pk2(q[2 * 65], q[3 * 65]); o[2] = pk2(q[4 * 65], q[5 * 65]); o[3] = pk2(q[6 * 65], q[7 * 65]);
        const int nn = n0 + n; const int row = mode == 0 ? nn : ((nn >> 7) * 256 + (mode == 2 ? 128 : 0) + (nn & 127));
        *(u32x4*)(WT + (size_t)row * K + k0 + 8 * c) = o; }
    asm volatile("s_waitcnt lgkmcnt(0)" ::: "memory");
}

__device__ __forceinline__ void phase_prologue(const Params& p, unsigned char* shm) {
    const int tid = l_tid(), lane = tid & 63, w = tid >> 6;
    const int gw = l_bid() * 8 + w, NGW = GRID * 8;
    float* scr = (float*)(shm + w * 16640);
    constexpr int I_G = (DM / 64) * (FF / 64), I_D = (FF / 64) * (DM / 64), I_IN = (DM / 64) * (2048 / 64), I_OUT = (DM / 64) * (DM / 64);
    constexpr int PER_L = 4 * I_G + 2 * I_D + I_IN + I_OUT;
    for (int it = gw; it < 2 * PER_L; it += NGW) {
        const int l = it / PER_L; int r = it % PER_L;
        unsigned char* wl = p.ws + WS_W + (size_t)l * LW_END;
        const size_t offF = (size_t)l * DM * FF, offN = (size_t)l * DM;
        if (r < I_G) { transpose_item(p.in[2] + offF, DM, FF, (bf16_t*)(wl + LW_GU1), p.in[1] + offN, 1, scr, r, lane); continue; } r -= I_G;
        if (r < I_G) { transpose_item(p.in[3] + offF, DM, FF, (bf16_t*)(wl + LW_GU1), p.in[1] + offN, 2, scr, r, lane); continue; } r -= I_G;
        if (r < I_D) { transpose_item(p.in[4] + offF, FF, DM, (bf16_t*)(wl + LW_D1), nullptr, 0, scr, r, lane); continue; } r -= I_D;
        if (r < I_IN) { transpose_item(p.in[6] + (size_t)l * DM * 2048, DM, 2048, (bf16_t*)(wl + LW_IN), p.in[5] + offN, 0, scr, r, lane); continue; } r -= I_IN;
        if (r < I_OUT) { transpose_item(p.in[21] + (size_t)l * DM * DM, DM, DM, (bf16_t*)(wl + LW_OUT), nullptr, 0, scr, r, lane); continue; } r -= I_OUT;
        if (r < I_G) { transpose_item(p.in[23] + offF, DM, FF, (bf16_t*)(wl + LW_GU2), p.in[22] + offN, 1, scr, r, lane); continue; } r -= I_G;
        if (r < I_G) { transpose_item(p.in[24] + offF, DM, FF, (bf16_t*)(wl + LW_GU2), p.in[22] + offN, 2, scr, r, lane); continue; } r -= I_G;
        transpose_item(p.in[25] + offF, FF, DM, (bf16_t*)(wl + LW_D2), nullptr, 0, scr, r, lane);
    }
    {
        const float* x = p.in[0]; bf16_t* XB = (bf16_t*)(p.ws + WS_XB); float* ssq0 = (float*)(p.ws + WS_SSQ);
        for (int row = gw; row < T_TOK; row += NGW) {
            const f32x4* xr = (const f32x4*)(x + (size_t)row * DM) + lane;
            u32x2* o = (u32x2*)(XB + (size_t)row * DM) + lane;
            float s = 0.f;
#pragma unroll
            for (int j = 0; j < 4; ++j) { const f32x4 v = xr[64 * j]; s += v[0] * v[0] + v[1] * v[1] + v[2] * v[2] + v[3] * v[3];
                u32x2 q; q[0] = pk2(v[0], v[1]); q[1] = pk2(v[2], v[3]); o[64 * j] = q; }
            s = wave_sum(s);
            if (lane < 16) ssq0[(size_t)row * 16 + lane] = lane == 0 ? s : 0.f;
        }
    }
    const int gt = l_bid() * 512 + tid, NT = GRID * 512;
    for (int i = gt; i < 2 * 4 * 128 * 128 / 4; i += NT) {
        const int l = i / (4 * 128 * 128 / 4), r = i % (4 * 128 * 128 / 4);
        const f32x4 v = ((const f32x4*)p.in[8])[i]; u32x2 q; q[0] = pk2(v[0], v[1]); q[1] = pk2(v[2], v[3]);
        ((u32x2*)(p.ws + WS_W + (size_t)l * LW_END + LW_SGU))[r] = q;
    }
    for (int i = gt; i < 2 * 16 * 1536; i += NT) {
        const int l = i / (16 * 1536), r = i % (16 * 1536), n = r / 1536, k = r % 1536;
        const float v = n < 8 ? p.in[15][((size_t)l * 1536 + k) * 8 + n] : p.in[17][((size_t)l * 1536 + k) * 8 + (n - 8)];
        ((bf16_t*)(p.ws + WS_W + (size_t)l * LW_END + LW_GT))[r] = (bf16_t)(pk2(v, 0.f) & 0xffffu);
    }
}

struct PrepPre { u32x2 x[12]; u32x4 wsl[2]; };
__device__ __forceinline__ void prep_issue(PrepPre& r, const bf16_t* ZXO, const bf16_t* WgT, size_t T0, int c, int hh, int g, int tq, int tid) {
    const int ch = hh * 128 + 4 * g;
#pragma unroll
    for (int k = 0; k < 12; ++k) {
        const int pos = c * 128 + 8 * tq + k - 2;
        const bf16_t* zb = ZXO + (T0 - 2) * 1024;
        if (pos >= 0 && pos < SEQ) r.x[k] = *(const u32x2*)(zb + (unsigned)((8 * tq + k) * 1024 + ch));
        else r.x[k] = (u32x2){0u, 0u};
    }
#pragma unroll
    for (int q = 0; q < 2; ++q) { const int ii = tid + 512 * q; if (ii < 768) { const int n = ii / 48, rem = ii % 48, part = rem >> 4, c16 = rem & 15;
        r.wsl[q] = *(const u32x4*)(WgT + (size_t)n * 1536 + part * 512 + hh * 128 + c16 * 8); } else r.wsl[q] = (u32x4){0u, 0u, 0u, 0u}; }
}
__device__ __forceinline__ void phase_prep(const Params& p, int l, unsigned char* shm) {
    const int tid = l_tid(), lane = tid & 63, w = tid >> 6, fr = lane & 15, fq = lane >> 4;
    const bf16_t* ZXO = (const bf16_t*)(p.ws + WS_ZXO);
    bf16_t* Qb = (bf16_t*)(p.ws + WS_Q); bf16_t* Kb = (bf16_t*)(p.ws + WS_K); bf16_t* Vb = (bf16_t*)(p.ws + WS_V); bf16_t* XCb = (bf16_t*)(p.ws + WS_XC);
    const float* conv_w = p.in[10] + (size_t)l * 5 * 512; const float* conv_b = p.in[11] + (size_t)l * 512;
    const float* wq = p.in[12] + (size_t)l * 128 * 16; const float* wk = p.in[13] + (size_t)l * 128 * 16; const float* wv = p.in[14] + (size_t)l * 128 * 16;
    const bf16_t* WgT = (const bf16_t*)(p.ws + WS_W + (size_t)l * LW_END + LW_GT);
    const float* gbf = p.in[16] + l * 8; const float* gbb = p.in[18] + l * 8;
    float* bvec = (float*)(p.ws + WS_BV); float* avec = (float*)(p.ws + WS_AV); float* cmvec = (float*)(p.ws + WS_CM); float* scal = (float*)(p.ws + WS_SC);
    constexpr int TP = 784;
    unsigned char* tile = shm; float* Gs = (float*)(shm + 128 * TP); unsigned char* wgl = shm + 128 * TP + 8192;
    float* wl = (float*)(shm + 128 * TP + 8192 + 16 * TP);
    for (int u = l_bid(); u < 256; u += GRID) {
        const int c = u & 63; const size_t T0 = (size_t)u * 128;
        const int g = tid & 31, tq = tid >> 5;
        for (int i = tid; i < 2304; i += 512) {
            f32x4 v;
            if (i < 640) v = ((const f32x4*)conv_w)[i]; else if (i < 768) v = ((const f32x4*)conv_b)[i - 640];
            else if (i < 1280) v = ((const f32x4*)wq)[i - 768]; else if (i < 1792) v = ((const f32x4*)wk)[i - 1280]; else v = ((const f32x4*)wv)[i - 1792];
            ((f32x4*)wl)[i] = v;
        }
        PrepPre r;
        prep_issue(r, ZXO, WgT, T0, c, 0, g, tq, tid);
        __syncthreads();
        f32x4 gacc = {0.f, 0.f, 0.f, 0.f};
        for (int hh = 0; hh < 4; ++hh) {
            int tqv = tq, gv = g; asm volatile("" : "+v"(tqv), "+v"(gv));
            const int ch = hh * 128 + 4 * gv;
            f32x4 cw[5];
#pragma unroll
            for (int j = 0; j < 5; ++j) cw[j] = *(const f32x4*)(wl + j * 512 + ch);
            const f32x4 cb = *(const f32x4*)(wl + 2560 + ch);
            const volatile f32x4* wqv = (const volatile f32x4*)(wl + 3072 + (hh * 32 + gv) * 16);
            bf16_t* xb0 = XCb + T0 * 512;
#pragma unroll
            for (int i = 0; i < 8; ++i) {
                const int t = 8 * tqv + i;
                f32x4 xs[5];
#pragma unroll
                for (int j = 0; j < 5; ++j) { const u32x2 rr = r.x[i + j]; xs[j] = (f32x4){bflo(rr[0]), bfhi(rr[0]), bflo(rr[1]), bfhi(rr[1])}; }
                f32x4 a = cb;
#pragma unroll
                for (int j = 0; j < 5; ++j) a += cw[j] * xs[j];
                f32x4 xc;
#pragma unroll
                for (int e = 0; e < 4; ++e) xc[e] = a[e] * __builtin_amdgcn_rcpf(1.f + __expf(-a[e]));
                f32x4 q, k, v;
                { const f32x4 w0 = wqv[0], w1 = wqv[1], w2 = wqv[2], w3 = wqv[3]; q = xc[0] * w0 + xc[1] * w1 + xc[2] * w2 + xc[3] * w3; }
                { const f32x4 w0 = wqv[512], w1 = wqv[513], w2 = wqv[514], w3 = wqv[515]; k = (xc[0] * w0 + xc[1] * w1 + xc[2] * w2 + xc[3] * w3) * 0.08838834764831845f; }
                { const f32x4 w0 = wqv[1024], w1 = wqv[1025], w2 = wqv[1026], w3 = wqv[1027]; v = xs[2][0] * w0 + xs[2][1] * w1 + xs[2][2] * w2 + xs[2][3] * w3; }
                u32x2 qp, kp, vp;
                qp[0] = pk2(q[0], q[1]); qp[1] = pk2(q[2], q[3]); kp[0] = pk2(k[0], k[1]); kp[1] = pk2(k[2], k[3]);
                vp[0] = pk2(v[0], v[1]); vp[1] = pk2(v[2], v[3]);
                { u32x2 xp; xp[0] = pk2(xc[0], xc[1]); xp[1] = pk2(xc[2], xc[3]); *(u32x2*)(xb0 + (unsigned)((8 * tqv + i) * 512 + ch)) = xp; }
                unsigned char* tr = tile + t * TP + gv * 8;
                *(u32x2*)(tr) = qp; *(u32x2*)(tr + 256) = kp; *(u32x2*)(tr + 512) = vp;
            }
#pragma unroll
            for (int q = 0; q < 2; ++q) { const int ii = tid + 512 * q; if (ii < 768) { const int n = ii / 48, rem = ii % 48, part = rem >> 4, c16 = rem & 15;
                *(u32x4*)(wgl + n * TP + part * 256 + c16 * 16) = r.wsl[q]; } }
            if (hh < 3) prep_issue(r, ZXO, WgT, T0, c, hh + 1, gv, tqv, tid);
            __syncthreads();
#pragma unroll
            for (int kk = 0; kk < 12; ++kk) {
                const bf16x8 a = *(const bf16x8*)(tile + (16 * w + fr) * TP + kk * 64 + fq * 16);
                const bf16x8 b = *(const bf16x8*)(wgl + fr * TP + kk * 64 + fq * 16);
                gacc = __builtin_amdgcn_mfma_f32_16x16x32_bf16(b, a, gacc, 0, 0, 0);
            }
            __builtin_amdgcn_sched_barrier(0);
#pragma unroll
            for (int i = 0; i < 12; ++i) { if ((i & 3) == 0) __builtin_amdgcn_sched_barrier(0);
                const int rem = tid + 512 * (i & 3), row = rem >> 4, cc = rem & 15;
                const u32x4 vv = *(const u32x4*)(tile + row * TP + (i >> 2) * 256 + cc * 16);
                bf16_t* dst = ((i >> 2) == 0 ? Qb : (i >> 2) == 1 ? Kb : Vb) + T0 * 512 + hh * 128;
                *(u32x4*)(dst + (unsigned)(row * 512 + cc * 8)) = vv; }
            __syncthreads();
        }
        { const f32x4 bias = (fq < 2) ? *(const f32x4*)(gbf + fq * 4) : *(const f32x4*)(gbb + (fq - 2) * 4);
          *(f32x4*)(Gs + (16 * w + fr) * 16 + fq * 4) = gacc + bias; }
        __syncthreads();
        {
            const int dir = w >> 2, hs = w & 3;
            const int e0 = 2 * lane, e1 = e0 + 1, p0 = dir ? 127 - e0 : e0, p1 = dir ? 127 - e1 : e1;
            const float ig0 = Gs[p0 * 16 + dir * 8 + hs], ig1 = Gs[p1 * 16 + dir * 8 + hs];
            const float lf0 = logsig(Gs[p0 * 16 + dir * 8 + 4 + hs]), lf1 = logsig(Gs[p1 * 16 + dir * 8 + 4 + hs]);
            const float s1 = lf0 + lf1; float incl = s1;
#pragma unroll
            for (int off = 1; off < 64; off <<= 1) { const float t = __shfl_up(incl, off); if (lane >= off) incl += t; }
            const float excl = incl - s1, b0 = excl + lf0, b1 = excl + s1, btot = __shfl(incl, 63);
            const float a0 = ig0 - b0, a1 = ig1 - b1, c1 = fmaxf(a0, a1); float mx = c1;
#pragma unroll
            for (int off = 1; off < 64; off <<= 1) { const float t = __shfl_up(mx, off); if (lane >= off) mx = fmaxf(mx, t); }
            float ex = __shfl_up(mx, 1); if (lane == 0) ex = -INFINITY;
            const float cm0 = fmaxf(ex, a0), cm1 = fmaxf(ex, c1), amax = __shfl(mx, 63);
            const size_t idx = ((size_t)(u * 4 + hs)) * 2 + dir;
            bvec[idx * 128 + p0] = b0; bvec[idx * 128 + p1] = b1; avec[idx * 128 + p0] = a0; avec[idx * 128 + p1] = a1;
            cmvec[idx * 128 + p0] = cm0; cmvec[idx * 128 + p1] = cm1;
            if (lane == 0) { scal[idx * 2] = btot; scal[idx * 2 + 1] = amax; }
        }
        __syncthreads();
    }
}

__device__ __forceinline__ void load_tile_T(unsigned char* dst, const bf16_t* src, size_t gp, int tid) {
    const int sp = tid & 63, cg0 = tid >> 6;
#pragma unroll
    for (int it = 0; it < 2; ++it) {
        const int chunk = cg0 + 8 * it;
        const bf16_t* sp0 = src + (size_t)(2 * sp) * gp + chunk * 8;
        const u32x4 r0 = *(const u32x4*)sp0, r1 = *(const u32x4*)(sp0 + gp);
#pragma unroll
        for (int e = 0; e < 8; ++e) {
            const unsigned w0 = r0[e >> 1], w1 = r1[e >> 1];
            const unsigned lo = (e & 1) ? (w0 >> 16) : (w0 & 0xffffu), hi = (e & 1) ? (w1 & 0xffff0000u) : (w1 << 16);
            *(unsigned*)(dst + (chunk * 8 + e) * MP + sp * 4) = lo | hi;
        }
    }
}

struct StPre { u32x4 k[2][2], v[2][2]; float a; };
__device__ __forceinline__ void state_issue(StPre& r, const Params& p, int unit, int tid) {
    const int u = unit >> 2, hh = unit & 3; const size_t T0 = (size_t)u * 128;
    const bf16_t* Kb = (const bf16_t*)(p.ws + WS_K); const bf16_t* Vb = (const bf16_t*)(p.ws + WS_V);
    const float* avec = (const float*)(p.ws + WS_AV); const float* scal = (const float*)(p.ws + WS_SC);
    const int sp = tid & 63, cg0 = tid >> 6;
#pragma unroll
    for (int it = 0; it < 2; ++it) { const size_t o = (T0 + 2 * sp) * 512 + hh * 128 + (cg0 + 8 * it) * 8;
        r.k[it][0] = *(const u32x4*)(Kb + o); r.k[it][1] = *(const u32x4*)(Kb + o + 512);
        r.v[it][0] = *(const u32x4*)(Vb + o); r.v[it][1] = *(const u32x4*)(Vb + o + 512); }
    const int t2 = tid & 255, dir = t2 >> 7, s = t2 & 127; const size_t idx = (size_t)unit * 2 + dir;
    r.a = avec[idx * 128 + s] - scal[idx * 2 + 1];
}
__device__ __forceinline__ void phase_state(const Params& p, unsigned char* shm) {
    const int tid = l_tid(), lane = tid & 63, w = tid >> 6, fr = lane & 15, fq = lane >> 4;
    bf16_t* CS = (bf16_t*)(p.ws + WS_CS); float* DN = (float*)(p.ws + WS_DN);
    unsigned char* VT = shm; unsigned char* KTF = shm + MBUF; unsigned char* KTB = shm + 2 * MBUF; float* wk = (float*)(shm + 4 * MBUF);
    int unit = 4 * l_bid(); const int uend = unit + 4;
    StPre r;
    if (unit < 1024) state_issue(r, p, unit, tid);
    for (; unit < uend && unit < 1024; ++unit) {
        if (tid < 256) wk[tid] = __expf(r.a);
        __syncthreads();
        {
            const int sp = tid & 63, cg0 = tid >> 6;
            const float wf0 = wk[2 * sp], wf1 = wk[2 * sp + 1], wb0 = wk[128 + 2 * sp], wb1 = wk[128 + 2 * sp + 1];
#pragma unroll
            for (int it = 0; it < 2; ++it) {
                const int chunk = cg0 + 8 * it;
#pragma unroll
                for (int e = 0; e < 8; ++e) {
                    const unsigned w0 = r.v[it][0][e >> 1], w1 = r.v[it][1][e >> 1];
                    const unsigned lo = (e & 1) ? (w0 >> 16) : (w0 & 0xffffu), hi = (e & 1) ? (w1 & 0xffff0000u) : (w1 << 16);
                    *(unsigned*)(VT + (chunk * 8 + e) * MP + sp * 4) = lo | hi;
                    const float k0 = bfel(r.k[it][0], e), k1 = bfel(r.k[it][1], e);
                    *(unsigned*)(KTF + (chunk * 8 + e) * MP + sp * 4) = pk2(k0 * wf0, k1 * wf1);
                    *(unsigned*)(KTB + (chunk * 8 + e) * MP + sp * 4) = pk2(k0 * wb0, k1 * wb1);
                }
            }
        }
        __syncthreads();
        if (unit + 1 < uend) state_issue(r, p, unit + 1, tid);
#pragma unroll
        for (int dir = 0; dir < 2; ++dir) {
            f32x4 acc[8]; zero8(acc);
            wave_gemm128(acc, VT + 16 * w * MP, dir ? KTB : KTF, fr, fq);
            bf16_t* dst = CS + ((size_t)unit * 2 + dir) * 16384 + (16 * w + fr) * 128 + 4 * fq;
#pragma unroll
            for (int n = 0; n < 8; ++n) { u32x2 o; o[0] = pk2(acc[n][0], acc[n][1]); o[1] = pk2(acc[n][2], acc[n][3]); *(u32x2*)(dst + n * 16) = o; }
        }
        {
            const int k = tid >> 2, part = tid & 3;
#pragma unroll
            for (int dir = 0; dir < 2; ++dir) {
                const unsigned char* base = (dir ? KTB : KTF) + k * MP + part * 64;
                float sm = 0.f;
#pragma unroll
                for (int i = 0; i < 4; ++i) { const u32x4 q = *(const u32x4*)(base + i * 16);
#pragma unroll
                    for (int e = 0; e < 4; ++e) sm += bflo(q[e]) + bfhi(q[e]); }
                sm += __shfl_xor(sm, 1); sm += __shfl_xor(sm, 2);
                if (part == 0) DN[((size_t)unit * 2 + dir) * 128 + k] = sm;
            }
        }
        __syncthreads();
    }
}

struct SgPre { u32x4 v[2][2]; };
__device__ __forceinline__ void sgu_issue(SgPre& r, const Params& p, int unit, int tid) {
    const int u = unit >> 2, hh = unit & 3; const size_t T0 = (size_t)u * 128;
    const bf16_t* ZUV = (const bf16_t*)(p.ws + WS_ZUV);
    const int sp = tid & 63, cg0 = tid >> 6;
#pragma unroll
    for (int it = 0; it < 2; ++it) { const size_t o = (T0 + 2 * sp) * 1024 + 512 + hh * 128 + (cg0 + 8 * it) * 8;
        r.v[it][0] = *(const u32x4*)(ZUV + o); r.v[it][1] = *(const u32x4*)(ZUV + o + 1024); }
}
__device__ __forceinline__ void phase_sgu(const Params& p, int l, unsigned char* shm) {
    const int tid = l_tid(), lane = tid & 63, w = tid >> 6, fr = lane & 15, fq = lane >> 4;
    bf16_t* ZUV = (bf16_t*)(p.ws + WS_ZUV);
    unsigned char* WS = shm; unsigned char* VHT = shm + MBUF; float* part = (float*)(shm + 4 * MBUF);
    const int G = GRID; int unit = l_bid();
    if (unit >= 1024) return;
    const int hh = unit & 3;
    const bf16_t* Wsb = (const bf16_t*)(p.ws + WS_W + (size_t)l * LW_END + LW_SGU);
    const float* gnb = p.in[7] + (size_t)l * 512; const float* bsb = p.in[9] + (size_t)l * 512;
    SgPre r;
    sgu_issue(r, p, unit, tid);
    int staged = -1;
    for (; unit < 1024; unit += G) {
        const int u = unit >> 2, hu = unit & 3; const size_t T0 = (size_t)u * 128;
        if (staged != hu) { load_tile(WS, Wsb + (size_t)hu * 128 * 128, 128, tid); staged = hu; }
        const int sp = tid & 63, cg0 = tid >> 6;
        {
            float s0 = 0.f, q0 = 0.f, s1 = 0.f, q1 = 0.f;
#pragma unroll
            for (int it = 0; it < 2; ++it)
#pragma unroll
                for (int e = 0; e < 4; ++e) { const float a0 = bflo(r.v[it][0][e]), a1 = bfhi(r.v[it][0][e]), b0 = bflo(r.v[it][1][e]), b1 = bfhi(r.v[it][1][e]);
                    s0 += a0 + a1; q0 += a0 * a0 + a1 * a1; s1 += b0 + b1; q1 += b0 * b0 + b1 * b1; }
            *(f32x4*)(part + (cg0 * 128 + 2 * sp) * 2) = (f32x4){s0, q0, s1, q1};
        }
        __syncthreads();
        {
            float s0 = 0.f, q0 = 0.f, s1 = 0.f, q1 = 0.f;
#pragma unroll
            for (int ww = 0; ww < 8; ++ww) { const f32x4 t = *(const f32x4*)(part + (ww * 128 + 2 * sp) * 2); s0 += t[0]; q0 += t[1]; s1 += t[2]; q1 += t[3]; }
            const float mu0 = s0 * (1.f / 128.f), mu1 = s1 * (1.f / 128.f);
            const float rs0 = rsqrtf(fmaxf(q0 * (1.f / 128.f) - mu0 * mu0, 0.f) + EPSN), rs1 = rsqrtf(fmaxf(q1 * (1.f / 128.f) - mu1 * mu1, 0.f) + EPSN);
            const float* gn = gnb + hu * 128;
#pragma unroll
            for (int it = 0; it < 2; ++it) {
                const int chunk = cg0 + 8 * it;
                const f32x4 g0 = *(const f32x4*)(gn + chunk * 8), g1 = *(const f32x4*)(gn + chunk * 8 + 4);
#pragma unroll
                for (int e = 0; e < 8; ++e) {
                    const float gg = e < 4 ? g0[e & 3] : g1[e & 3];
                    const float a = (bfel(r.v[it][0], e) - mu0) * rs0 * gg, b = (bfel(r.v[it][1], e) - mu1) * rs1 * gg;
                    *(unsigned*)(VHT + (chunk * 8 + e) * MP + sp * 4) = pk2(a, b);
                }
            }
        }
        __syncthreads();
        if (unit + G < 1024) sgu_issue(r, p, unit + G, tid);
        const int pr = 16 * w + fr; const float bias = bsb[hu * 128 + pr];
        bf16_t* up = ZUV + (T0 + pr) * 1024 + hu * 128 + 4 * fq;
        u32x2 uu[8];
#pragma unroll
        for (int n = 0; n < 8; ++n) uu[n] = *(const u32x2*)(up + n * 16);
        f32x4 acc[8]; zero8(acc);
        wave_gemm128(acc, WS + 16 * w * MP, VHT, fr, fq);
        {
#pragma unroll
            for (int n = 0; n < 8; ++n) {
                u32x2 o; o[0] = pk2(bflo(uu[n][0]) * (acc[n][0] + bias), bfhi(uu[n][0]) * (acc[n][1] + bias));
                o[1] = pk2(bflo(uu[n][1]) * (acc[n][2] + bias), bfhi(uu[n][1]) * (acc[n][3] + bias));
                *(u32x2*)(up + n * 16) = o;
            }
        }
        __syncthreads();
    }
}

__device__ __forceinline__ void phase_scan_sgu(const Params& p, int l, unsigned char* shm) {
    static_assert(GRID * 512 == 32 * 4096 && 1024 / GRID == 4, "one scan item per thread, four SGU units per block");
    const int tid = l_tid(), lane = tid & 63, w = tid >> 6, fr = lane & 15, fq = lane >> 4;
    bf16_t* ZUV = (bf16_t*)(p.ws + WS_ZUV);
    unsigned char* WS = shm; unsigned char* VHT = shm + MBUF; float* part = (float*)(shm + 4 * MBUF);
    const int G = GRID; int unit = l_bid();
    if (unit >= 1024) return;
    const int hh = unit & 3;
    const bf16_t* Wsb = (const bf16_t*)(p.ws + WS_W + (size_t)l * LW_END + LW_SGU);
    const float* gnb = p.in[7] + (size_t)l * 512; const float* bsb = p.in[9] + (size_t)l * 512;
    SgPre r;
    sgu_issue(r, p, unit, tid);
    int staged = -1;
    bf16_t* CS = (bf16_t*)(p.ws + WS_CS); float* DN = (float*)(p.ws + WS_DN);
    const float* scal = (const float*)(p.ws + WS_SC); float* mst = (float*)(p.ws + WS_MS);
    const int chain = l_bid() >> 3, q4 = (l_bid() & 7) * 512 + tid, sb = chain >> 3, shh = (chain >> 1) & 3, sdir = chain & 1;
    const bool has_n = q4 < 128;
    float C0 = 0.f, C1 = 0.f, C2 = 0.f, C3 = 0.f, nn = 0.f;
    float* cf1 = (float*)(shm + 2 * MBUF); float* cf2 = cf1 + 64; float* cmp = cf1 + 128;
    if (tid < 64) { const int st = tid, c = sdir ? 63 - st : st; const size_t idx = ((size_t)((sb * 64 + c) * 4 + shh)) * 2 + sdir; cf1[st] = scal[idx * 2]; cf2[st] = scal[idx * 2 + 1]; }
    __syncthreads();
    if (tid == 0) { float sm = 0.f;
#pragma unroll 8
        for (int st = 0; st < 64; ++st) { const float bt = cf1[st], am = cf2[st], mm = fmaxf(sm, am);
            cmp[st] = sm; cf1[st] = __expf(sm - mm); cf2[st] = __expf(am - mm); sm = bt + mm; } }
    __syncthreads();
    int kb = 0;
    for (; unit < 1024; unit += G, ++kb) {
        u32x2 sd[8]; float sdn[8];
#define SCAN_ISSUE(ST0) _Pragma("unroll") for (int jj = 0; jj < 8; ++jj) { const int st = (ST0) + jj, c = sdir ? 63 - st : st; const size_t idx = ((size_t)((sb * 64 + c) * 4 + shh)) * 2 + sdir; \
            sd[jj] = *(const u32x2*)(CS + idx * 16384 + q4 * 4); sdn[jj] = has_n ? DN[idx * 128 + q4] : 0.f; }
#define SCAN_CONSUME(ST0) _Pragma("unroll") for (int jj = 0; jj < 8; ++jj) { const int st = (ST0) + jj, c = sdir ? 63 - st : st; const size_t idx = ((size_t)((sb * 64 + c) * 4 + shh)) * 2 + sdir; \
            u32x2 o; o[0] = pk2(C0, C1); o[1] = pk2(C2, C3); *(u32x2*)(CS + idx * 16384 + q4 * 4) = o; \
            if (has_n) DN[idx * 128 + q4] = nn; \
            if (q4 == 0) mst[idx] = cmp[st]; \
            const float f1 = cf1[st], f2 = cf2[st]; \
            C0 = f1 * C0 + f2 * bflo(sd[jj][0]); C1 = f1 * C1 + f2 * bfhi(sd[jj][0]); C2 = f1 * C2 + f2 * bflo(sd[jj][1]); C3 = f1 * C3 + f2 * bfhi(sd[jj][1]); \
            nn = f1 * nn + f2 * sdn[jj]; }
        SCAN_ISSUE(16 * kb)
        const int u = unit >> 2, hu = unit & 3; const size_t T0 = (size_t)u * 128;
        if (staged != hu) { load_tile(WS, Wsb + (size_t)hu * 128 * 128, 128, tid); staged = hu; }
        const int sp = tid & 63, cg0 = tid >> 6;
        {
            float s0 = 0.f, q0 = 0.f, s1 = 0.f, q1 = 0.f;
#pragma unroll
            for (int it = 0; it < 2; ++it)
#pragma unroll
                for (int e = 0; e < 4; ++e) { const float a0 = bflo(r.v[it][0][e]), a1 = bfhi(r.v[it][0][e]), b0 = bflo(r.v[it][1][e]), b1 = bfhi(r.v[it][1][e]);
                    s0 += a0 + a1; q0 += a0 * a0 + a1 * a1; s1 += b0 + b1; q1 += b0 * b0 + b1 * b1; }
            *(f32x4*)(part + (cg0 * 128 + 2 * sp) * 2) = (f32x4){s0, q0, s1, q1};
        }
        __syncthreads();
        {
            float s0 = 0.f, q0 = 0.f, s1 = 0.f, q1 = 0.f;
#pragma unroll
            for (int ww = 0; ww < 8; ++ww) { const f32x4 t = *(const f32x4*)(part + (ww * 128 + 2 * sp) * 2); s0 += t[0]; q0 += t[1]; s1 += t[2]; q1 += t[3]; }
            const float mu0 = s0 * (1.f / 128.f), mu1 = s1 * (1.f / 128.f);
            const float rs0 = rsqrtf(fmaxf(q0 * (1.f / 128.f) - mu0 * mu0, 0.f) + EPSN), rs1 = rsqrtf(fmaxf(q1 * (1.f / 128.f) - mu1 * mu1, 0.f) + EPSN);
            const float* gn = gnb + hu * 128;
#pragma unroll
            for (int it = 0; it < 2; ++it) {
                const int chunk = cg0 + 8 * it;
                const f32x4 g0 = *(const f32x4*)(gn + chunk * 8), g1 = *(const f32x4*)(gn + chunk * 8 + 4);
#pragma unroll
                for (int e = 0; e < 8; ++e) {
                    const float gg = e < 4 ? g0[e & 3] : g1[e & 3];
                    const float a = (bfel(r.v[it][0], e) - mu0) * rs0 * gg, b = (bfel(r.v[it][1], e) - mu1) * rs1 * gg;
                    *(unsigned*)(VHT + (chunk * 8 + e) * MP + sp * 4) = pk2(a, b);
                }
            }
        }
        __syncthreads();
        SCAN_CONSUME(16 * kb)
        SCAN_ISSUE(16 * kb + 8)
        if (unit + G < 1024) sgu_issue(r, p, unit + G, tid);
        const int pr = 16 * w + fr; const float bias = bsb[hu * 128 + pr];
        bf16_t* up = ZUV + (T0 + pr) * 1024 + hu * 128 + 4 * fq;
        u32x2 uu[8];
#pragma unroll
        for (int n = 0; n < 8; ++n) uu[n] = *(const u32x2*)(up + n * 16);
        f32x4 acc[8]; zero8(acc);
        wave_gemm128(acc, WS + 16 * w * MP, VHT, fr, fq);
        {
#pragma unroll
            for (int n = 0; n < 8; ++n) {
                u32x2 o; o[0] = pk2(bflo(uu[n][0]) * (acc[n][0] + bias), bfhi(uu[n][0]) * (acc[n][1] + bias));
                o[1] = pk2(bflo(uu[n][1]) * (acc[n][2] + bias), bfhi(uu[n][1]) * (acc[n][3] + bias));
                *(u32x2*)(up + n * 16) = o;
            }
        }
        __syncthreads();
        SCAN_CONSUME(16 * kb + 8)
#undef SCAN_ISSUE
#undef SCAN_CONSUME
    }
}

__device__ __forceinline__ void phase_scan(const Params& p) {
    const int gt = l_bid() * 512 + l_tid(), NT = GRID * 512;
    bf16_t* CS = (bf16_t*)(p.ws + WS_CS); float* DN = (float*)(p.ws + WS_DN);
    const float* scal = (const float*)(p.ws + WS_SC); float* mst = (float*)(p.ws + WS_MS);
    for (int item = gt; item < 32 * 4096; item += NT) {
        const int chain = item >> 12, q4 = item & 4095, b = chain >> 3, hh = (chain >> 1) & 3, dir = chain & 1;
        float m = 0.f, C0 = 0.f, C1 = 0.f, C2 = 0.f, C3 = 0.f;
        for (int s0 = 0; s0 < 64; s0 += 8) {
            u32x2 d[8]; float bt[8], am[8];
#pragma unroll
            for (int j = 0; j < 8; ++j) { const int st = s0 + j, c = dir ? 63 - st : st; const size_t idx = ((size_t)((b * 64 + c) * 4 + hh)) * 2 + dir;
                d[j] = *(const u32x2*)(CS + idx * 16384 + q4 * 4); bt[j] = scal[idx * 2]; am[j] = scal[idx * 2 + 1]; }
#pragma unroll
            for (int j = 0; j < 8; ++j) { const int st = s0 + j, c = dir ? 63 - st : st; const size_t idx = ((size_t)((b * 64 + c) * 4 + hh)) * 2 + dir;
                u32x2 o; o[0] = pk2(C0, C1); o[1] = pk2(C2, C3); *(u32x2*)(CS + idx * 16384 + q4 * 4) = o;
                if (q4 == 0) mst[idx] = m;
                const float mm = fmaxf(m, am[j]), f1 = __expf(m - mm), f2 = __expf(am[j] - mm);
                C0 = f1 * C0 + f2 * bflo(d[j][0]); C1 = f1 * C1 + f2 * bfhi(d[j][0]); C2 = f1 * C2 + f2 * bflo(d[j][1]); C3 = f1 * C3 + f2 * bfhi(d[j][1]);
                m = bt[j] + mm; }
        }
    }
    for (int item = gt; item < 32 * 128; item += NT) {
        const int chain = item >> 7, k = item & 127, b = chain >> 3, hh = (chain >> 1) & 3, dir = chain & 1;
        float m = 0.f, n = 0.f;
        for (int s0 = 0; s0 < 64; s0 += 8) {
            float d[8], bt[8], am[8];
#pragma unroll
            for (int j = 0; j < 8; ++j) { const int st = s0 + j, c = dir ? 63 - st : st; const size_t idx = ((size_t)((b * 64 + c) * 4 + hh)) * 2 + dir;
                d[j] = DN[idx * 128 + k]; bt[j] = scal[idx * 2]; am[j] = scal[idx * 2 + 1]; }
#pragma unroll
            for (int j = 0; j < 8; ++j) { const int st = s0 + j, c = dir ? 63 - st : st; const size_t idx = ((size_t)((b * 64 + c) * 4 + hh)) * 2 + dir;
                DN[idx * 128 + k] = n;
                const float mm = fmaxf(m, am[j]), f1 = __expf(m - mm), f2 = __expf(am[j] - mm);
                n = f1 * n + f2 * d[j]; m = bt[j] + mm; }
        }
    }
}

struct QKPre { u32x4 q[4], k[4], cf[4], v[2][2]; float va, vM, vb, vn, m; };
__device__ __forceinline__ void issue_qk(QKPre& r, const Params& p, int unit, int tid) {
    const int u = unit >> 2, hh = unit & 3; const size_t ub = (size_t)u * 128 * 512 + hh * 128;
    const bf16_t* Qb = (const bf16_t*)(p.ws + WS_Q) + ub; const bf16_t* Kb = (const bf16_t*)(p.ws + WS_K) + ub; const bf16_t* Vb = (const bf16_t*)(p.ws + WS_V) + ub;
    const bf16_t* Cf = (const bf16_t*)(p.ws + WS_CS) + (size_t)unit * 2 * 16384;
#pragma unroll
    for (int i = 0; i < 4; ++i) { const int id = tid + 512 * i, row = id >> 4, cc = id & 15;
        r.q[i] = *(const u32x4*)(Qb + row * 512 + cc * 8); r.k[i] = *(const u32x4*)(Kb + row * 512 + cc * 8); r.cf[i] = *(const u32x4*)(Cf + row * 128 + cc * 8); }
    const int sp = tid & 63, cg0 = tid >> 6;
#pragma unroll
    for (int it = 0; it < 2; ++it) { const bf16_t* vp = Vb + (2 * sp) * 512 + (cg0 + 8 * it) * 8; r.v[it][0] = *(const u32x4*)vp; r.v[it][1] = *(const u32x4*)(vp + 512); }
    const int t2 = tid & 255; const int vo = unit * 256 + t2;
    const float m = ((const float*)(p.ws + WS_MS))[unit * 2 + (t2 >> 7)];
    r.va = ((const float*)(p.ws + WS_AV))[vo]; r.vM = fmaxf(m, ((const float*)(p.ws + WS_CM))[vo]); r.vb = ((const float*)(p.ws + WS_BV))[vo]; r.vn = ((const float*)(p.ws + WS_DN))[vo]; r.m = m;
}
__device__ __forceinline__ void unit_out(const Params& p, int l, unsigned char* shm, int unit, QKPre& pre, int next) {
    const int tid = l_tid(), lane = tid & 63, w = tid >> 6, fr = lane & 15, fq = lane >> 4;
    const int u = unit >> 2, hh = unit & 3; const size_t T0 = (size_t)u * 128;
    const bf16_t* Qb = (const bf16_t*)(p.ws + WS_Q); const bf16_t* Kb = (const bf16_t*)(p.ws + WS_K); const bf16_t* Vb = (const bf16_t*)(p.ws + WS_V);
    const bf16_t* XCb = (const bf16_t*)(p.ws + WS_XC); const bf16_t* ZXO = (const bf16_t*)(p.ws + WS_ZXO); bf16_t* ZUV = (bf16_t*)(p.ws + WS_ZUV);
    const bf16_t* CS = (const bf16_t*)(p.ws + WS_CS); const float* DN = (const float*)(p.ws + WS_DN);
    const float* bvec = (const float*)(p.ws + WS_BV); const float* avec = (const float*)(p.ws + WS_AV); const float* cmvec = (const float*)(p.ws + WS_CM);
    const float* mst = (const float*)(p.ws + WS_MS);
    const float* mhn = p.in[19] + (size_t)l * 512; const float* skip = p.in[20] + (size_t)l * 512;
    unsigned char* QS = shm; unsigned char* KS = shm + MBUF; unsigned char* VT = shm + 2 * MBUF; unsigned char* CX = shm + 3 * MBUF;
    float* vec = (float*)(shm + 4 * MBUF);
#pragma unroll
    for (int i = 0; i < 4; ++i) { const int id = tid + 512 * i, row = id >> 4, cc = id & 15; *(u32x4*)(QS + row * MP + cc * 16) = pre.q[i]; *(u32x4*)(KS + row * MP + cc * 16) = pre.k[i]; }
#pragma unroll
    for (int i = 0; i < 4; ++i) { const int id = tid + 512 * i, row = id >> 4, cc = id & 15; *(u32x4*)(CX + row * MP + cc * 16) = pre.cf[i]; }
    {
        const int sp = tid & 63, cg0 = tid >> 6;
#pragma unroll
        for (int it = 0; it < 2; ++it)
#pragma unroll
            for (int e = 0; e < 8; ++e) {
                const unsigned w0 = pre.v[it][0][e >> 1], w1 = pre.v[it][1][e >> 1];
                const unsigned lo = (e & 1) ? (w0 >> 16) : (w0 & 0xffffu), hi = (e & 1) ? (w1 & 0xffff0000u) : (w1 << 16);
                *(unsigned*)(VT + ((cg0 + 8 * it) * 8 + e) * MP + sp * 4) = lo | hi;
            }
    }
    if (tid < 256) { const int dir = tid >> 7, s = tid & 127;
        vec[dir * 128 + s] = pre.va; vec[256 + dir * 128 + s] = pre.vM; vec[512 + dir * 128 + s] = pre.vb; vec[768 + dir * 128 + s] = pre.vn;
        if (s == 0) vec[1280 + dir] = pre.m; }
    __syncthreads();
    {
        const int j = tid >> 2, part = tid & 3;
        const unsigned char* qp = QS + j * MP + part * 64;
        float df = 0.f, db = 0.f;
#pragma unroll
        for (int i = 0; i < 4; ++i) { const u32x4 r = *(const u32x4*)(qp + i * 16);
#pragma unroll
            for (int e = 0; e < 4; ++e) { const int k = part * 32 + i * 8 + 2 * e; const float q0 = bflo(r[e]), q1 = bfhi(r[e]);
                df += q0 * vec[768 + k] + q1 * vec[768 + k + 1]; db += q0 * vec[896 + k] + q1 * vec[896 + k + 1]; } }
        df += __shfl_xor(df, 1); df += __shfl_xor(df, 2); db += __shfl_xor(db, 1); db += __shfl_xor(db, 2);
        if (part == 0) { vec[1024 + j] = df; vec[1152 + j] = db; }
    }
    u32x4 cbr[4];
#pragma unroll
    for (int i = 0; i < 4; ++i) { const int id = tid + 512 * i, row = id >> 4, cc = id & 15; cbr[i] = *(const u32x4*)(CS + ((size_t)unit * 2 + 1) * 16384 + row * 128 + cc * 8); }
    f32x4 S[8]; zero8(S);
    wave_gemm128(S, QS + 16 * w * MP, KS, fr, fq);
    __syncthreads();
    const int j = 16 * w + fr;
    float scf, scb;
    {
        const float Mfj = vec[256 + j], Mbj = vec[384 + j], bfj = vec[512 + j], bbj = vec[640 + j], nqfj = vec[1024 + j], nqbj = vec[1152 + j], mf = vec[1280], mb = vec[1281];
        f32x4 Sb[8]; float rf = 0.f, rb = 0.f;
#pragma unroll
        for (int n = 0; n < 8; ++n) {
            const int s0 = n * 16 + 4 * fq;
            const f32x4 af4 = *(const f32x4*)(vec + s0), ab4 = *(const f32x4*)(vec + 128 + s0);
#pragma unroll
            for (int i = 0; i < 4; ++i) {
                const int s = s0 + i;
                const float wf = (s <= j) ? __expf(af4[i] - Mfj) : 0.f, wb = (s >= j) ? __expf(ab4[i] - Mbj) : 0.f;
                const float sv = S[n][i];
                S[n][i] = sv * wf; Sb[n][i] = sv * wb; rf += sv * wf; rb += sv * wb;
            }
        }
        rf += __shfl_xor(rf, 16); rf += __shfl_xor(rf, 32); rb += __shfl_xor(rb, 16); rb += __shfl_xor(rb, 32);
        const float wif = __expf(mf - Mfj), wib = __expf(mb - Mbj);
        const float nqf = wif * nqfj + rf, nqb = wib * nqbj + rb;
        const float invf = 1.f / fmaxf(fabsf(nqf), __expf(-(bfj + Mfj))), invb = 1.f / fmaxf(fabsf(nqb), __expf(-(bbj + Mbj)));
        scf = wif * invf; scb = wib * invb;
#pragma unroll
        for (int n = 0; n < 8; ++n) {
            const f32x4 P = S[n] * invf + Sb[n] * invb;
            u32x2 o; o[0] = pk2(P[0], P[1]); o[1] = pk2(P[2], P[3]);
            *(u32x2*)(KS + j * MP + (n * 16 + 4 * fq) * 2) = o;
        }
    }
    f32x4 aF[8], aI[8]; zero8(aF); zero8(aI);
    wave_gemm128(aF, QS + 16 * w * MP, CX, fr, fq);
    wave_gemm128(aI, KS + 16 * w * MP, VT, fr, fq);
    __syncthreads();
#pragma unroll
    for (int i = 0; i < 4; ++i) { const int id = tid + 512 * i, row = id >> 4, cc = id & 15; *(u32x4*)(CX + row * MP + cc * 16) = cbr[i]; }
    u32x2 xcr[8], ogr[8];
#pragma unroll
    for (int n = 0; n < 8; ++n) { const int ch = hh * 128 + n * 16 + 4 * fq;
        xcr[n] = *(const u32x2*)(XCb + (T0 + j) * 512 + ch); ogr[n] = *(const u32x2*)(ZXO + (T0 + j) * 1024 + 512 + ch); }
    if (next >= 0) issue_qk(pre, p, next, tid);
    __syncthreads();
    f32x4 aB[8]; zero8(aB);
    wave_gemm128(aB, QS + 16 * w * MP, CX, fr, fq);
    float sum = 0.f;
#pragma unroll
    for (int n = 0; n < 8; ++n) { aI[n] = aI[n] + aF[n] * scf + aB[n] * scb; sum += aI[n][0] + aI[n][1] + aI[n][2] + aI[n][3]; }
    sum += __shfl_xor(sum, 16); sum += __shfl_xor(sum, 32);
    const float mu = sum * (1.f / 128.f);
    float s2 = 0.f;
#pragma unroll
    for (int n = 0; n < 8; ++n) { const f32x4 d = aI[n] - mu; s2 += d[0] * d[0] + d[1] * d[1] + d[2] * d[2] + d[3] * d[3]; }
    s2 += __shfl_xor(s2, 16); s2 += __shfl_xor(s2, 32);
    const float rs = rsqrtf(s2 * (1.f / 128.f) + EPSN);
#pragma unroll
    for (int n = 0; n < 8; ++n) {
        const int ch = hh * 128 + n * 16 + 4 * fq;
        const f32x4 gn = *(const f32x4*)(mhn + ch), sk = *(const f32x4*)(skip + ch);
        const u32x2 xr = xcr[n], orr = ogr[n];
        const f32x4 xc = {bflo(xr[0]), bfhi(xr[0]), bflo(xr[1]), bfhi(xr[1])}, og = {bflo(orr[0]), bfhi(orr[0]), bflo(orr[1]), bfhi(orr[1])};
        f32x4 y;
#pragma unroll
        for (int i = 0; i < 4; ++i) y[i] = ((aI[n][i] - mu) * rs * gn[i] + sk[i] * xc[i]) * sigmoidf_(og[i]);
        u32x2 o; o[0] = pk2(y[0], y[1]); o[1] = pk2(y[2], y[3]);
        *(u32x2*)(ZUV + (T0 + j) * 1024 + 512 + ch) = o;
    }
    __syncthreads();
}

__device__ __forceinline__ void phase_final(const Params& p) {
    const int tid = l_tid(), lane = tid & 63, w = tid >> 6;
    const int gw = l_bid() * 8 + w, NGW = GRID * 8;
    const float* ssq = (const float*)(p.ws + WS_SSQ) + (size_t)6 * T_TOK * 16; const float* g = p.in[26];
    const bf16_t* XB = (const bf16_t*)(p.ws + WS_XB);
    f32x4 gg[4];
#pragma unroll
    for (int j = 0; j < 4; ++j) gg[j] = ((const f32x4*)g)[lane + 64 * j];
    for (int row = gw; row < T_TOK; row += NGW) {
        float s = lane < 16 ? ssq[(size_t)row * 16 + lane] : 0.f;
        s += __shfl_xor(s, 1); s += __shfl_xor(s, 2); s += __shfl_xor(s, 4); s += __shfl_xor(s, 8);
        s = __shfl(s, 0);
        const float rstd = rsqrtf(s * (1.f / DM) + EPSN);
        const u32x2* xb = (const u32x2*)(XB + (size_t)row * DM) + lane;
        f32x4* o = (f32x4*)(p.out + (size_t)row * DM) + lane;
#pragma unroll
        for (int j = 0; j < 4; ++j) { const u32x2 t = xb[64 * j]; o[64 * j] = (f32x4){bflo(t[0]), bfhi(t[0]), bflo(t[1]), bfhi(t[1])} * rstd * gg[j]; }
    }
}

__global__ __launch_bounds__(512, 2) void mega_fwd(Params p) {
    extern __shared__ __attribute__((aligned(16))) unsigned char shm[];
    cg::grid_group grid = cg::this_grid();
    float* ssq = (float*)(p.ws + WS_SSQ);
    bf16_t* XB = (bf16_t*)(p.ws + WS_XB); bf16_t* Hh = (bf16_t*)(p.ws + WS_U);
    bf16_t* ZUV = (bf16_t*)(p.ws + WS_ZUV); bf16_t* ZXO = (bf16_t*)(p.ws + WS_ZXO);
    volatile LAS unsigned* st = (volatile LAS unsigned*)((PG8_LAS unsigned char*)shm + LDS_MAIN);
    if (threadIdx.x == 0) { st[0] = 0u; st[1] = 0u; st[2] = 0u; st[3] = 0u; }
    __syncthreads();
    XcdBarrier xbar = xcd_barrier_post((unsigned*)(p.ws + WS_BAR), st);
    for (int ph = p.ph_lo; ph < p.ph_hi; ++ph) {
        if (ph >= 1 && ph <= 20 && (ph - 1) % 10 == 4) continue;
        if (ph > p.ph_lo) { if (p.ph_hi > 1000) grid.sync(); else xcd_barrier(xbar); }
        if (ph == 0) { phase_prologue(p, shm); continue; }
        if (ph == 21) { phase_final(p); continue; }
        const int l = (ph - 1) / 10, s = (ph - 1) % 10;
        const unsigned char* wl = p.ws + WS_W + (size_t)l * LW_END;
        const float* ss_a = ssq + (size_t)(3 * l) * T_TOK * 16;
        float* ss_b = ssq + (size_t)(3 * l + 1) * T_TOK * 16;
        float* ss_c = ssq + (size_t)(3 * l + 2) * T_TOK * 16;
        float* ss_d = ssq + (size_t)(3 * l + 3) * T_TOK * 16;
        switch (s) {
        case 0: { EpiUp E{Hh, nullptr, 0}; run_gemm_rs(shm, XB, (const bf16_t*)(wl + LW_GU1), 2 * FF, DM, E, ss_a); } break;
        case 1: { EpiRes<false> E{nullptr, XB, ss_b, 0.5f}; run_gemm(shm, Hh, (const bf16_t*)(wl + LW_D1), DM, FF, E); } break;
        case 2: { EpiWin E{ZUV, ZXO, nullptr, 0}; run_gemm_rs(shm, XB, (const bf16_t*)(wl + LW_IN), 2048, DM, E, ss_b); } break;
        case 3: phase_prep(p, l, shm); asm volatile("s_waitcnt vmcnt(0)" ::: "memory"); __syncthreads(); phase_state(p, shm); break;
        case 4: break;
        case 5: phase_scan_sgu(p, l, shm); break;
        case 6: { QKPre pre; int k = l_bid(); issue_qk(pre, p, k, l_tid());
                  for (; k < 1024; k += GRID) unit_out(p, l, shm, k, pre, k + GRID < 1024 ? k + GRID : -1); } break;
        case 7: { EpiRes<false> E{nullptr, XB, ss_c, 1.0f}; run_gemm(shm, ZUV, (const bf16_t*)(wl + LW_OUT), DM, DM, E); } break;
        case 8: { EpiUp E{Hh, nullptr, 0}; run_gemm_rs(shm, XB, (const bf16_t*)(wl + LW_GU2), 2 * FF, DM, E, ss_c); } break;
        case 9: { EpiRes<false> E{nullptr, XB, ss_d, 0.5f}; run_gemm(shm, Hh, (const bf16_t*)(wl + LW_D2), DM, FF, E); } break;
        }
    }
}

#ifndef ONE_LAUNCH
#define ONE_LAUNCH 1
#endif
extern "C" void kernel_launch(void* const* d_in, const int* in_sizes, int n_in, void* d_out, int out_size, void* d_ws, size_t ws_size, hipStream_t stream) {
    static int grid = 0;
    if (grid == 0) {
        if (n_in != 27 || ws_size < WS_END) { fprintf(stderr, "kernel_launch: unexpected n_in %d or ws_size %zu (need %zu)\n", n_in, ws_size, (size_t)WS_END); grid = -1; return; }
        int dev = 0, cus = 0, per_cu = 0;
        hipGetDevice(&dev);
        hipDeviceGetAttribute(&cus, hipDeviceAttributeMultiprocessorCount, dev);
        if (hipFuncSetAttribute((const void*)mega_fwd, hipFuncAttributeMaxDynamicSharedMemorySize, LDS_BYTES) != hipSuccess) { fprintf(stderr, "kernel_launch: hipFuncSetAttribute failed\n"); grid = -1; return; }
        if (hipOccupancyMaxActiveBlocksPerMultiprocessor(&per_cu, (const void*)mega_fwd, 512, LDS_BYTES) != hipSuccess || per_cu < 1) { fprintf(stderr, "kernel_launch: occupancy query says %d\n", per_cu); per_cu = 1; }
        (void)hipGetLastError();
        grid = cus * per_cu;
        if (grid < GRID) { fprintf(stderr, "kernel_launch: this build needs %d co-resident workgroups, device offers %d\n", GRID, grid); grid = -1; return; }
        grid = GRID;
    }
    if (grid < 0) return;
    (void)hipMemsetAsync((unsigned char*)d_ws + WS_BAR, 0, (size_t)XCD_BAR_WORDS * 4, stream);
    Params p{};
    for (int i = 0; i < 27; ++i) p.in[i] = (const float*)d_in[i];
    p.out = (float*)d_out; p.ws = (unsigned char*)d_ws;
#if ONE_LAUNCH
    p.ph_lo = 0; p.ph_hi = 22;
    void* args[] = {&p};
    hipError_t e = hipLaunchCooperativeKernel((const void*)mega_fwd, dim3(grid), dim3(512), args, LDS_BYTES, stream);
    if (e != hipSuccess) fprintf(stderr, "cooperative launch failed: %s (grid %d)\n", hipGetErrorString(e), grid);
#else
    for (int ph = 0; ph < 22; ++ph) { p.ph_lo = ph; p.ph_hi = ph + 1; hipLaunchKernelGGL(mega_fwd, dim3(grid), dim3(512), LDS_BYTES, stream, p); }
#endif
}
```

```cpp
#include <hip/hip_runtime.h>
#include <hip/hip_cooperative_groups.h>
#include <cstdio>
namespace cg = cooperative_groups;
#ifndef GEMM_SP2
#define GEMM_SP2 true
#endif
#ifndef GEMM_ALIGN
#define GEMM_ALIGN true
#endif
constexpr int GRID = 256;

typedef unsigned short bf16_t;
typedef short bf16x8 __attribute__((ext_vector_type(8)));
typedef float f32x4 __attribute__((ext_vector_type(4)));
typedef unsigned u32x4 __attribute__((ext_vector_type(4)));
typedef unsigned u32x2 __attribute__((ext_vector_type(2)));

__device__ __forceinline__ int l_tid() { int t = threadIdx.x; asm volatile("" : "+v"(t)); return t; }
__device__ __forceinline__ int l_bid() { int t = blockIdx.x; asm volatile("" : "+s"(t)); return t; }

namespace pg8 {
#define PG8_LAS __attribute__((address_space(3)))
constexpr int BM = 256, BK = 64, HALF = 128, HTB = HALF * BK * 2  , STAGE_BYTES = 8 * HTB, NXCD = 8, WGM = 8;

__host__ __device__ __forceinline__ int lds_byte(int r, int c) { const int st = (r >> 4) * 2 + (c >> 5), rr = r & 15, cc = c & 31, ob = rr * 64 + cc * 2; return st * 1024 + (ob ^ (((ob >> 9) & 1) << 5)); }
__host__ __device__ __forceinline__ void stage_rc(int b, int& R, int& C) { const int st = b / 1024, sb = b % 1024, swz = sb ^ (((sb >> 9) & 1) << 5); R = (st >> 1) * 16 + swz / 64; C = (st & 1) * 32 + (swz % 64) / 2; }
__host__ __device__ __forceinline__ int perm32(int rho) { const int n = rho >> 4, i = rho & 15; return 8 * (i >> 2) + 4 * n + (i & 3); }

struct Unit { int pm, pn; };
struct Gemm { const bf16_t* A; const bf16_t* Bt; int M, N, K; };

struct StaticOrder {
    int nM, nN, nwg, G, c;
    __host__ __device__ void init(int M, int N, int G_, int c_) { nM = M / BM; nN = N / BM; nwg = nM * nN; G = G_; c = c_; }
    __host__ __device__ bool next(int i, Unit& u) const {
        const long L = (long)i * G + c; if (L >= nwg) return false;
        int wgid = (int)L; { const int q = nwg / NXCD, r = nwg % NXCD, xcd = wgid % NXCD, off = wgid / NXCD; wgid = (xcd < r ? xcd * (q + 1) : r * (q + 1) + (xcd - r) * q) + off; }
        const int nig = WGM * nN, gid = wgid / nig, fm = gid * WGM, gsz = (nM - fm) < WGM ? (nM - fm) : WGM;
        u.pm = fm + ((wgid % nig) % gsz); u.pn = (wgid % nig) / gsz; return true;
    }
    __device__ __forceinline__ void a_ready(const Unit&) const {}
    __device__ __forceinline__ void done(const Unit&) const {}
};

template <class Epi, class Sched, bool ALIGN_EPI = false, bool SP2 = false>
__device__ __forceinline__ void gemm_phase(PG8_LAS unsigned char* lds, const Gemm g, const Sched& S, const Epi& E) {
    const int tid = l_tid(), wid = __builtin_amdgcn_readfirstlane(tid >> 6), lane = tid & 63, wr = wid >> 2, wc = wid & 3, fr = lane & 15, fq = lane >> 4;
    const int K = g.K, nt = K / BK;
    unsigned voffA[2], voffB[2];
#pragma unroll
    for (int i = 0; i < 2; ++i) { int R, C; stage_rc(tid * 16 + i * 8192, R, C); const int Rb = Epi::PERM ? ((R & ~31) + perm32(R & 31)) : R;
        voffA[i] = (unsigned)(R * K + C) * 2u; voffB[i] = (unsigned)(Rb * K + C) * 2u; }
    const size_t kstep = (size_t)(BK * 2);
    const size_t hstep = (size_t)HALF * K * 2;
    const size_t tstep = 2 * hstep;
    const unsigned ldsw = (unsigned)wid * 1024u;
    const int aoff = lds_byte(wr * 64 + fr, fq * 8), boff = lds_byte(wc * 32 + fr, fq * 8);
#define PG8_SA(b, h) (((b) * 2 + (h)) * HTB)
#define PG8_SB(b, h) ((4 + (b) * 2 + (h)) * HTB)
#define PG8_STAGE(bufoff, gbase, voff) do { _Pragma("unroll") for (int _i = 0; _i < 2; ++_i) \
        __builtin_amdgcn_global_load_lds((const unsigned*)((const char*)(gbase) + (voff)[_i]), (PG8_LAS unsigned*)(lds + (bufoff) + ldsw + _i * 8192), 16, 0, 0); } while (0)
#define PG8_LDA(dst, b, h) do { _Pragma("unroll") for (int m = 0; m < 4; ++m) _Pragma("unroll") for (int k = 0; k < 2; ++k) dst[m][k] = *(const PG8_LAS bf16x8*)(lds + PG8_SA(b, h) + aoff + m * 2048 + k * 1024); } while (0)
#define PG8_LDB(dst, b, h) do { _Pragma("unroll") for (int n = 0; n < 2; ++n) _Pragma("unroll") for (int k = 0; k < 2; ++k) dst[n][k] = *(const PG8_LAS bf16x8*)(lds + PG8_SB(b, h) + boff + n * 2048 + k * 1024); } while (0)
#define PG8_MMA(ai, bj, At, Bt) do { __builtin_amdgcn_s_setprio(1); _Pragma("unroll") for (int m = 0; m < 4; ++m) _Pragma("unroll") for (int n = 0; n < 2; ++n) _Pragma("unroll") for (int k = 0; k < 2; ++k) \
        acc[ai][bj][m][n] = __builtin_amdgcn_mfma_f32_16x16x32_bf16(Bt[n][k], At[m][k], acc[ai][bj][m][n], 0, 0, 0); __builtin_amdgcn_s_setprio(0); } while (0)
#define PG8_WAIT_V(n) asm volatile("s_waitcnt vmcnt(" #n ")" ::: "memory")
#define PG8_WAIT_L(n) asm volatile("s_waitcnt lgkmcnt(" #n ")" ::: "memory")
#define PG8_BAR __builtin_amdgcn_s_barrier()
#define PG8_SCHED __builtin_amdgcn_sched_barrier(0)
    Unit cur, nxt; int ui = 0;
    if (!S.next(0, cur)) return;
    f32x4 acc[2][2][4][2];
#pragma unroll
    for (int a = 0; a < 2; ++a)
#pragma unroll
        for (int b = 0; b < 2; ++b)
#pragma unroll
            for (int m = 0; m < 4; ++m)
#pragma unroll
                for (int n = 0; n < 2; ++n) acc[a][b][m][n] = (f32x4){0.f, 0.f, 0.f, 0.f};
    bf16x8 At[4][2], B0[2][2], B1[2][2];
    const char* cA = (const char*)g.A + (size_t)cur.pm * tstep; const char* cB = (const char*)g.Bt + (size_t)cur.pn * tstep;
    S.a_ready(cur);
    if constexpr (SP2) {
        PG8_STAGE(PG8_SB(0, 0), cB, voffB); PG8_STAGE(PG8_SB(0, 1), cB + hstep, voffB); PG8_STAGE(PG8_SA(0, 0), cA, voffA); PG8_STAGE(PG8_SA(0, 1), cA + hstep, voffA);
        if (wr == 1) PG8_BAR;
        PG8_WAIT_V(2); PG8_BAR;
        PG8_STAGE(PG8_SB(1, 0), cB + kstep, voffB); PG8_STAGE(PG8_SA(1, 0), cA + kstep, voffA); PG8_STAGE(PG8_SB(1, 1), cB + hstep + kstep, voffB);
        PG8_WAIT_V(6); PG8_BAR;
    } else {
        PG8_STAGE(PG8_SB(0, 0), cB, voffB); PG8_STAGE(PG8_SA(0, 0), cA, voffA); PG8_STAGE(PG8_SB(0, 1), cB + hstep, voffB); PG8_STAGE(PG8_SA(0, 1), cA + hstep, voffA);
        if (wr == 1) PG8_BAR;
        PG8_WAIT_V(4); PG8_BAR;
        PG8_STAGE(PG8_SB(1, 0), cB + kstep, voffB); PG8_STAGE(PG8_SA(1, 0), cA + kstep, voffA); PG8_STAGE(PG8_SB(1, 1), cB + hstep + kstep, voffB);
        PG8_WAIT_V(6); PG8_BAR;
    }
    for (;;) {
        const bool has_next = S.next(ui + 1, nxt);
        const char* nA = has_next ? (const char*)g.A + (size_t)nxt.pm * tstep : cA; const char* nB = has_next ? (const char*)g.Bt + (size_t)nxt.pn * tstep : cB;
        for (int t = 0; t < nt; t += 2) {
            const bool last = (t == nt - 2);
            const char* a1 = cA + (size_t)(t + 1) * kstep;
            const char* a2 = last ? nA : cA + (size_t)(t + 2) * kstep; const char* b2 = last ? nB : cB + (size_t)(t + 2) * kstep;
            const char* a3 = a2 + kstep; const char* b3 = b2 + kstep;
            if (last && has_next) S.a_ready(nxt);
            if constexpr (SP2) {
            PG8_LDB(B0, 0, 0); PG8_LDB(B1, 0, 1); PG8_SCHED; PG8_LDA(At, 0, 0); PG8_STAGE(PG8_SA(1, 1), a1 + hstep, voffA);
            PG8_WAIT_V(8); PG8_WAIT_L(0); PG8_BAR; PG8_MMA(0, 0, At, B0); PG8_MMA(0, 1, At, B1); PG8_BAR; PG8_SCHED;
            PG8_LDA(At, 0, 1); PG8_STAGE(PG8_SB(0, 0), b2, voffB); PG8_STAGE(PG8_SB(0, 1), b2 + hstep, voffB); PG8_STAGE(PG8_SA(0, 0), a2, voffA);
            PG8_WAIT_V(8); PG8_WAIT_L(0); PG8_BAR; PG8_MMA(1, 0, At, B0); PG8_MMA(1, 1, At, B1); PG8_BAR; PG8_SCHED;
            PG8_LDB(B0, 1, 0); PG8_LDB(B1, 1, 1); PG8_SCHED; PG8_LDA(At, 1, 0); PG8_STAGE(PG8_SA(0, 1), a2 + hstep, voffA);
            PG8_WAIT_V(8); PG8_WAIT_L(0); PG8_BAR; PG8_MMA(0, 0, At, B0); PG8_MMA(0, 1, At, B1); PG8_BAR; PG8_SCHED;
            PG8_LDA(At, 1, 1); PG8_STAGE(PG8_SB(1, 0), b3, voffB); PG8_STAGE(PG8_SB(1, 1), b3 + hstep, voffB); PG8_STAGE(PG8_SA(1, 0), a3, voffA);
            PG8_WAIT_V(8); PG8_WAIT_L(0); PG8_BAR; PG8_MMA(1, 0, At, B0); PG8_MMA(1, 1, At, B1); PG8_BAR; PG8_SCHED;
            } else {
            PG8_LDB(B0, 0, 0); PG8_SCHED; PG8_LDA(At, 0, 0); PG8_STAGE(PG8_SA(1, 1), a1 + hstep, voffA);
            PG8_WAIT_L(8); PG8_BAR; PG8_WAIT_L(0); PG8_MMA(0, 0, At, B0); PG8_BAR; PG8_SCHED;
            PG8_LDB(B1, 0, 1); PG8_STAGE(PG8_SB(0, 0), b2, voffB);
            PG8_BAR; PG8_WAIT_L(0); PG8_MMA(0, 1, At, B1); PG8_BAR;
            PG8_LDA(At, 0, 1); PG8_STAGE(PG8_SA(0, 0), a2, voffA);
            PG8_BAR; PG8_WAIT_L(0); PG8_MMA(1, 0, At, B0); PG8_BAR; PG8_SCHED;
            PG8_STAGE(PG8_SB(0, 1), b2 + hstep, voffB);
            PG8_WAIT_V(6); PG8_BAR; PG8_MMA(1, 1, At, B1); PG8_BAR;
            PG8_LDB(B0, 1, 0); PG8_SCHED; PG8_LDA(At, 1, 0); PG8_STAGE(PG8_SA(0, 1), a2 + hstep, voffA);
            PG8_WAIT_L(8); PG8_BAR; PG8_WAIT_L(0); PG8_MMA(0, 0, At, B0); PG8_BAR; PG8_SCHED;
            PG8_LDB(B1, 1, 1); PG8_STAGE(PG8_SB(1, 0), b3, voffB);
            PG8_BAR; PG8_WAIT_L(0); PG8_MMA(0, 1, At, B1); PG8_BAR;
            PG8_LDA(At, 1, 1); PG8_STAGE(PG8_SA(1, 0), a3, voffA);
            PG8_BAR; PG8_WAIT_L(0); PG8_MMA(1, 0, At, B0); PG8_BAR; PG8_SCHED;
            PG8_STAGE(PG8_SB(1, 1), b3 + hstep, voffB);
            PG8_WAIT_V(6); PG8_BAR; PG8_MMA(1, 1, At, B1); PG8_BAR;
            }
        }
        if constexpr (ALIGN_EPI) { if (wr == 0) PG8_BAR; }
        if constexpr (!Epi::AFTER_DRAIN) { E(acc, cur, wr, wc, fr, fq); S.done(cur); }
        if (!has_next) break;
#pragma unroll
        for (int a = 0; a < 2; ++a)
#pragma unroll
            for (int b = 0; b < 2; ++b)
#pragma unroll
                for (int m = 0; m < 4; ++m)
#pragma unroll
                    for (int n = 0; n < 2; ++n) acc[a][b][m][n] = (f32x4){0.f, 0.f, 0.f, 0.f};
        cur = nxt; cA = nA; cB = nB; ++ui;
        if constexpr (ALIGN_EPI) { if (wr == 1) PG8_BAR; }
    }
    PG8_WAIT_V(0);
    if constexpr (!ALIGN_EPI) { if (wr == 0) PG8_BAR; }
    PG8_BAR;
    if constexpr (Epi::AFTER_DRAIN) { E.fused(acc, cur, wr, wc, fr, fq, lds, wid, lane); S.done(cur); }
#undef PG8_SA
#undef PG8_SB
#undef PG8_STAGE
#undef PG8_LDA
#undef PG8_LDB
#undef PG8_MMA
#undef PG8_WAIT_V
#undef PG8_WAIT_L
#undef PG8_BAR
#undef PG8_SCHED
}
}

#define XB_TMO      128
#define XB_XCNT(j)  (256  + 64 * (j))
#define XB_XSUB(j)  (1280 + 64 * (j))
#define XB_XGEN(j)  (2304 + 64 * (j))
#define XB_TOP      3328
#define XB_TOPGEN   3392
#define XCD_BAR_WORDS 3456
#define XB_SPIN_CAP (1u << 18)
#define LAS __attribute__((address_space(3)))

__device__ __forceinline__ unsigned xb_ld(unsigned* p)              { return __hip_atomic_load(p, __ATOMIC_RELAXED, __HIP_MEMORY_SCOPE_AGENT); }
__device__ __forceinline__ unsigned xb_add(unsigned* p, unsigned v) { return __hip_atomic_fetch_add(p, v, __ATOMIC_RELAXED, __HIP_MEMORY_SCOPE_AGENT); }
__device__ __forceinline__ unsigned xb_xcc_id() { return (unsigned)__builtin_amdgcn_s_getreg((3 << 11) | 20) & 0xFu; }
#define XB_SPIN(cond, bar) do { unsigned _sp = 0; while (cond) { __builtin_amdgcn_s_sleep(1); \
    if ((++_sp & 255u) == 0u) { if (xb_ld(&(bar)[XB_TMO])) break; if (_sp > XB_SPIN_CAP) { atomicAdd(&(bar)[XB_TMO], 1u); break; } } } } while (0)

struct XcdBarrier {
    unsigned* bar; unsigned x;
    volatile LAS unsigned* st;
};

__device__ __forceinline__ XcdBarrier xcd_barrier_post(unsigned* bar, volatile LAS unsigned* st) {
    XcdBarrier b; b.bar = bar; b.x = xb_xcc_id(); b.st = st;
    if (threadIdx.x == 0) (void)xb_add(&bar[XB_XCNT(b.x)], 1u);
    return b;
}
__device__ __forceinline__ void xcd_barrier_complete(unsigned* bar, unsigned x, unsigned& nloc, unsigned& nx) {
    const unsigned G = GRID;
    unsigned sum, cnt, mine, sp = 0u;
    for (;;) {
        sum = 0u; cnt = 0u; mine = 0u;
#pragma unroll
        for (unsigned j = 0; j < 16; ++j) { const unsigned c = xb_ld(&bar[XB_XCNT(j)]); sum += c; cnt += (c > 0u) ? 1u : 0u; mine = (j == x) ? c : mine; }
        if (sum == G) break;
        __builtin_amdgcn_s_sleep(1);
        if ((++sp & 255u) == 0u) { if (xb_ld(&bar[XB_TMO])) break; if (sp > XB_SPIN_CAP) { atomicAdd(&bar[XB_TMO], 1u); break; } }
    }
    nloc = mine > 0u ? mine : 1u; nx = cnt > 0u ? cnt : 1u;
}

__device__ __forceinline__ void xcd_barrier(const XcdBarrier& b) {
    asm volatile("s_waitcnt vmcnt(0)" ::: "memory");
    __syncthreads();
    if (threadIdx.x == 0) {
        unsigned* bar = b.bar;
        __builtin_amdgcn_s_waitcnt(0);
        unsigned nloc = b.st[0], nx = b.st[1];
        if (nloc == 0u) { xcd_barrier_complete(bar, b.x, nloc, nx); b.st[0] = nloc; b.st[1] = nx; }
        const unsigned old = xb_add(&bar[XB_XSUB(b.x)], 1u);
        const unsigned gen = old / nloc;
        if (old + 1u == (gen + 1u) * nloc) {
            __builtin_amdgcn_fence(__ATOMIC_RELEASE, "agent");
            asm volatile("s_waitcnt vmcnt(0)" ::: "memory");
            const unsigned og = xb_add(&bar[XB_TOP], 1u);
            const unsigned tg = og / nx;
            if (og + 1u == (tg + 1u) * nx) xb_add(&bar[XB_TOPGEN], 1u);
            else XB_SPIN(xb_ld(&bar[XB_TOPGEN]) == tg, bar);
            __builtin_amdgcn_fence(__ATOMIC_ACQUIRE, "agent");
            xb_add(&bar[XB_XGEN(b.x)], 1u);
            asm volatile("s_waitcnt vmcnt(0)" ::: "memory");
        } else {
            XB_SPIN(xb_ld(&bar[XB_XGEN(b.x)]) == gen, bar);
            __builtin_amdgcn_fence(__ATOMIC_ACQUIRE, "agent");
            asm volatile("s_waitcnt vmcnt(0)" ::: "memory");
        }
    }
    __syncthreads();
}


constexpr int T_TOK = 32768, DM = 1024, FF = 2816, SEQ = 8192, NCH = 64;
constexpr float EPSN = 1e-6f;
constexpr int MP = 272;
constexpr int MBUF = 128 * MP;
constexpr int LDS_MAIN = 157952;
static_assert(LDS_MAIN >= 4 * MBUF + 8192 && LDS_MAIN % 16 == 0, "LDS map");
constexpr int LDS_BYTES = LDS_MAIN + 16;

constexpr size_t SZ_WGU = (size_t)2 * FF * DM * 2, SZ_WD = (size_t)DM * FF * 2, SZ_WIN = (size_t)2048 * DM * 2, SZ_WOUT = (size_t)DM * DM * 2;
constexpr size_t SZ_SGUW = (size_t)4 * 128 * 128 * 2, SZ_WGT = (size_t)16 * 1536 * 2;
constexpr size_t LW_GU1 = 0, LW_D1 = LW_GU1 + SZ_WGU, LW_IN = LW_D1 + SZ_WD, LW_OUT = LW_IN + SZ_WIN, LW_GU2 = LW_OUT + SZ_WOUT, LW_D2 = LW_GU2 + SZ_WGU,
                 LW_SGU = LW_D2 + SZ_WD, LW_GT = LW_SGU + SZ_SGUW, LW_END = LW_GT + SZ_WGT;
constexpr size_t WS_W = 0;
constexpr size_t WS_XB = WS_W + 2 * LW_END;
constexpr size_t WS_U = WS_XB + (size_t)T_TOK * DM * 2;
constexpr size_t WS_ZUV = WS_U, WS_ZXO = WS_ZUV + (size_t)T_TOK * 1024 * 2, WS_Q = WS_ZXO + (size_t)T_TOK * 1024 * 2,
                 WS_K = WS_Q + (size_t)T_TOK * 512 * 2, WS_V = WS_K + (size_t)T_TOK * 512 * 2, WS_XC = WS_V + (size_t)T_TOK * 512 * 2,
                 WS_UEND = WS_XC + (size_t)T_TOK * 512 * 2;
static_assert(WS_UEND - WS_U >= (size_t)T_TOK * FF * 2, "H must fit the shared region");
constexpr size_t WS_SSQ = WS_UEND;
constexpr size_t WS_BV = WS_SSQ + (size_t)7 * T_TOK * 16 * 4, WS_AV = WS_BV + (size_t)2048 * 128 * 4, WS_CM = WS_AV + (size_t)2048 * 128 * 4,
                 WS_DN = WS_CM + (size_t)2048 * 128 * 4, WS_SC = WS_DN + (size_t)2048 * 128 * 4, WS_MS = WS_SC + (size_t)2048 * 2 * 4,
                 WS_BAR = WS_MS + (size_t)2048 * 4, WS_CS = (WS_BAR + (size_t)XCD_BAR_WORDS * 4 + 255) / 256 * 256,
                 WS_END = WS_CS + (size_t)2048 * 16384 * 2;

struct Params {
    const float* in[27];
    float* out;
    unsigned char* ws;
    int ph_lo, ph_hi;
};

typedef __bf16 bf16x2_t __attribute__((ext_vector_type(2)));
typedef float f32x2_t __attribute__((ext_vector_type(2)));
__device__ __forceinline__ unsigned pk2(float lo, float hi) { const f32x2_t v = {lo, hi}; const bf16x2_t b = __builtin_convertvector(v, bf16x2_t); return __builtin_bit_cast(unsigned, b); }
__device__ __forceinline__ float bflo(unsigned w) { return __uint_as_float(w << 16); }
__device__ __forceinline__ float bfhi(unsigned w) { return __uint_as_float(w & 0xffff0000u); }
__device__ __forceinline__ float bfel(const u32x4& v, int e) { const unsigned w = v[e >> 1]; return (e & 1) ? bfhi(w) : bflo(w); }
__device__ __forceinline__ float sigmoidf_(float x) { return __builtin_amdgcn_rcpf(1.f + __expf(-x)); }
__device__ __forceinline__ float gelu_tanh(float x) { const float y = 0.7978845608028654f * (x + 0.044715f * x * x * x); return x * __builtin_amdgcn_rcpf(1.f + __expf(-2.f * y)); }
__device__ __forceinline__ float logsig(float x) { return fminf(x, 0.f) - log1pf(expf(-fabsf(x))); }
__device__ __forceinline__ float wave_sum(float v) {
#pragma unroll
    for (int o = 1; o < 64; o <<= 1) v += __shfl_xor(v, o);
    return v;
}

__device__ __forceinline__ float row_ssq(const float* part, int row) {
    const f32x4* q = (const f32x4*)(part + (size_t)row * 16);
    const f32x4 a = q[0], b = q[1], c = q[2], d = q[3];
    return (((a[0] + a[1]) + (a[2] + a[3])) + ((b[0] + b[1]) + (b[2] + b[3]))) + (((c[0] + c[1]) + (c[2] + c[3])) + ((d[0] + d[1]) + (d[2] + d[3])));
}
__device__ __forceinline__ void wave_gemm128(f32x4 (&acc)[8], const unsigned char* Arows, const unsigned char* Brows, int fr, int fq) {
#pragma unroll
    for (int kk = 0; kk < 4; ++kk) {
        const bf16x8 a = *(const bf16x8*)(Arows + fr * MP + kk * 64 + fq * 16);
#pragma unroll
        for (int n = 0; n < 8; ++n) {
            const bf16x8 b = *(const bf16x8*)(Brows + (n * 16 + fr) * MP + kk * 64 + fq * 16);
            acc[n] = __builtin_amdgcn_mfma_f32_16x16x32_bf16(b, a, acc[n], 0, 0, 0);
        }
    }
}
__device__ __forceinline__ void zero8(f32x4 (&acc)[8]) {
#pragma unroll
    for (int n = 0; n < 8; ++n) acc[n] = (f32x4){0.f, 0.f, 0.f, 0.f};
}
__device__ __forceinline__ void load_tile(unsigned char* dst, const bf16_t* src, size_t gp, int tid) {
#pragma unroll
    for (int i = 0; i < 4; ++i) { const int id = tid + 512 * i, row = id >> 4, cc = id & 15;
        *(u32x4*)(dst + row * MP + cc * 16) = *(const u32x4*)(src + (size_t)row * gp + cc * 8); }
}

struct EpiUp {
    static constexpr bool PERM = true, AFTER_DRAIN = false;
    bf16_t* H; const PG8_LAS float* rs; int pm0;
    __device__ __forceinline__ void operator()(const f32x4 (&acc)[2][2][4][2], const pg8::Unit& u, int wr, int wc, int fr, int fq) const {
        const int row0 = u.pm * 256 + wr * 64 + fr, col = u.pn * 128 + wc * 32 + 8 * fq;
#pragma unroll
        for (int ai = 0; ai < 2; ++ai)
#pragma unroll
            for (int m = 0; m < 4; ++m) {
                const int row = row0 + ai * 128 + m * 16;
                const float rstd = rs[((u.pm - pm0) >> 3) * 256 + (row & 255)];
                float h[8];
#pragma unroll
                for (int n = 0; n < 2; ++n)
#pragma unroll
                    for (int i = 0; i < 4; ++i) { const float g = acc[ai][0][m][n][i] * rstd, uu = acc[ai][1][m][n][i] * rstd; h[4 * n + i] = g * uu * __builtin_amdgcn_rcpf(1.f + __expf(-g)); }
                u32x4 o; o[0] = pk2(h[0], h[1]); o[1] = pk2(h[2], h[3]); o[2] = pk2(h[4], h[5]); o[3] = pk2(h[6], h[7]);
                *(u32x4*)(H + (size_t)row * FF + col) = o;
            }
    }
};
template <bool RIN_F32> struct EpiRes {
    static constexpr bool PERM = true, AFTER_DRAIN = false;
    const float* Rin; bf16_t* XB; float* ssq; float scale;
    __device__ __forceinline__ void operator()(const f32x4 (&acc)[2][2][4][2], const pg8::Unit& u, int wr, int wc, int fr, int fq) const {
        static_assert(!RIN_F32, "the residual stream is bf16");
        const int row0 = u.pm * 256 + wr * 64 + fr, col0 = u.pn * 256 + wc * 32 + 8 * fq;
        u32x4 rb[4][2], ob[4][2];
#pragma unroll
        for (int m = 0; m < 4; ++m)
#pragma unroll
            for (int bj = 0; bj < 2; ++bj) rb[m][bj] = *(const u32x4*)(XB + (size_t)(row0 + m * 16) * DM + col0 + bj * 128);
#pragma unroll
        for (int ai = 0; ai < 2; ++ai) {
            float ssv[4];
#pragma unroll
            for (int m = 0; m < 4; ++m) {
                float ss = 0.f;
#pragma unroll
                for (int bj = 0; bj < 2; ++bj) {
                    const u32x4 t = rb[m][bj];
                    const f32x4 r0 = {bflo(t[0]), bfhi(t[0]), bflo(t[1]), bfhi(t[1])}, r1 = {bflo(t[2]), bfhi(t[2]), bflo(t[3]), bfhi(t[3])};
                    const f32x4 v0 = r0 + acc[ai][bj][m][0] * scale, v1 = r1 + acc[ai][bj][m][1] * scale;
                    u32x4 o; o[0] = pk2(v0[0], v0[1]); o[1] = pk2(v0[2], v0[3]); o[2] = pk2(v1[0], v1[1]); o[3] = pk2(v1[2], v1[3]);
                    ob[m][bj] = o;
                    ss += v0[0] * v0[0] + v0[1] * v0[1] + v0[2] * v0[2] + v0[3] * v0[3] + v1[0] * v1[0] + v1[1] * v1[1] + v1[2] * v1[2] + v1[3] * v1[3];
                }
                ss += __shfl_xor(ss, 16); ss += __shfl_xor(ss, 32);
                ssv[m] = ss;
            }
            if (ai == 0) {
#pragma unroll
                for (int m = 0; m < 4; ++m)
#pragma unroll
                    for (int bj = 0; bj < 2; ++bj) rb[m][bj] = *(const u32x4*)(XB + (size_t)(row0 + 128 + m * 16) * DM + col0 + bj * 128);
            }
#pragma unroll
            for (int m = 0; m < 4; ++m) {
                const int row = row0 + ai * 128 + m * 16;
#pragma unroll
                for (int bj = 0; bj < 2; ++bj) *(u32x4*)(XB + (size_t)row * DM + col0 + bj * 128) = ob[m][bj];
                if (fq == 0) ssq[(size_t)row * 16 + u.pn * 4 + wc] = ssv[m];
            }
        }
    }
};
struct EpiWin {
    static constexpr bool PERM = true, AFTER_DRAIN = false;
    bf16_t* ZUV; bf16_t* ZXO; const PG8_LAS float* rs; int pm0;
    __device__ __forceinline__ void operator()(const f32x4 (&acc)[2][2][4][2], const pg8::Unit& u, int wr, int wc, int fr, int fq) const {
        const bool act = u.pn < 4; bf16_t* dst = act ? ZUV : ZXO;
        const int row0 = u.pm * 256 + wr * 64 + fr, col0 = (u.pn & 3) * 256 + wc * 32 + 8 * fq;
#pragma unroll
        for (int ai = 0; ai < 2; ++ai)
#pragma unroll
            for (int m = 0; m < 4; ++m) {
                const int row = row0 + ai * 128 + m * 16;
                const float rstd = rs[((u.pm - pm0) >> 3) * 256 + (row & 255)];
#pragma unroll
                for (int bj = 0; bj < 2; ++bj) {
                    float h[8];
#pragma unroll
                    for (int n = 0; n < 2; ++n)
#pragma unroll
                        for (int i = 0; i < 4; ++i) { const float z = acc[ai][bj][m][n][i] * rstd; h[4 * n + i] = act ? gelu_tanh(z) : z; }
                    u32x4 o; o[0] = pk2(h[0], h[1]); o[1] = pk2(h[2], h[3]); o[2] = pk2(h[4], h[5]); o[3] = pk2(h[6], h[7]);
                    *(u32x4*)(dst + (size_t)row * 1024 + col0 + bj * 128) = o;
                }
            }
    }
};

template <class Epi>
__device__ __forceinline__ void run_gemm(unsigned char* shm, const bf16_t* A, const bf16_t* Bt, int N, int K, const Epi& E) {
    pg8::Gemm g{A, Bt, T_TOK, N, K};
    pg8::StaticOrder S; S.init(T_TOK, N, GRID, l_bid());
    pg8::gemm_phase<Epi, pg8::StaticOrder, GEMM_ALIGN, GEMM_SP2>((PG8_LAS unsigned char*)shm, g, S, E);
}

template <class Epi>
__device__ __forceinline__ void run_gemm_rs(unsigned char* shm, const bf16_t* A, const bf16_t* Bt, int N, int K, Epi& E, const float* ssq_part) {
    pg8::Gemm g{A, Bt, T_TOK, N, K};
    pg8::StaticOrder S; S.init(T_TOK, N, GRID, l_bid());
    pg8::Unit u0; if (!S.next(0, u0)) return;
    PG8_LAS float* rl = (PG8_LAS float*)(PG8_LAS unsigned char*)shm + 131072 / 4;
    const int tid = l_tid();
    for (int i = tid; i < 1024; i += 512) { const int pm = u0.pm + 8 * (i >> 8);
        if (pm < T_TOK / 256) rl[i] = rsqrtf(row_ssq(ssq_part, pm * 256 + (i & 255)) * (1.f / DM) + EPSN); }
    __syncthreads();
    E.rs = rl; E.pm0 = u0.pm;
    pg8::gemm_phase<Epi, pg8::StaticOrder, GEMM_ALIGN, GEMM_SP2>((PG8_LAS unsigned char*)shm, g, S, E);
}

__device__ __forceinline__ void transpose_item(const float* W, int K, int N, bf16_t* WT, const float* gain, int mode, float* scr, int item, int lane) {
    const int nblk = N / 64, kb = item / nblk, nb = item % nblk, k0 = 64 * kb, n0 = 64 * nb;
    const int r = lane >> 4, c4 = lane & 15;
#pragma unroll 8
    for (int i = 0; i < 16; ++i) { const int kk = 4 * i + r; f32x4 v = *(const f32x4*)(W + (size_t)(k0 + kk) * N + n0 + 4 * c4);
        if (gain) v = v * gain[k0 + kk];
        float* d = scr + kk * 65 + 4 * c4; d[0] = v[0]; d[1] = v[1]; d[2] = v[2]; d[3] = v[3]; }
    asm volatile("s_waitcnt lgkmcnt(0)" ::: "memory");
    const int c = lane & 7, nl = lane >> 3;
#pragma unroll
    for (int j = 0; j < 8; ++j) { const int n = nl + 8 * j; const float* q = scr + (8 * c) * 65 + n;
        u32x4 o; o[0] = pk2(q[0 * 65], q[1 * 65]); o[1] = pk2(q[2 * 65], q[3 * 65]); o[2] = pk2(q[4 * 65], q[5 * 65]); o[3] = pk2(q[6 * 65], q[7 * 65]);
        const int nn = n0 + n; const int row = mode == 0 ? nn : ((nn >> 7) * 256 + (mode == 2 ? 128 : 0) + (nn & 127));
        *(u32x4*)(WT + (size_t)row * K + k0 + 8 * c) = o; }
    asm volatile("s_waitcnt lgkmcnt(0)" ::: "memory");
}

__device__ __forceinline__ void phase_prologue(const Params& p, unsigned char* shm) {
    const int tid = l_tid(), lane = tid & 63, w = tid >> 6;
    const int gw = l_bid() * 8 + w, NGW = GRID * 8;
    float* scr = (float*)(shm + w * 16640);
    constexpr int I_G = (DM / 64) * (FF / 64), I_D = (FF / 64) * (DM / 64), I_IN = (DM / 64) * (2048 / 64), I_OUT = (DM / 64) * (DM / 64);
    constexpr int PER_L = 4 * I_G + 2 * I_D + I_IN + I_OUT;
    for (int it = gw; it < 2 * PER_L; it += NGW) {
        const int l = it / PER_L; int r = it % PER_L;
        unsigned char* wl = p.ws + WS_W + (size_t)l * LW_END;
        const size_t offF = (size_t)l * DM * FF, offN = (size_t)l * DM;
        if (r < I_G) { transpose_item(p.in[2] + offF, DM, FF, (bf16_t*)(wl + LW_GU1), p.in[1] + offN, 1, scr, r, lane); continue; } r -= I_G;
        if (r < I_G) { transpose_item(p.in[3] + offF, DM, FF, (bf16_t*)(wl + LW_GU1), p.in[1] + offN, 2, scr, r, lane); continue; } r -= I_G;
        if (r < I_D) { transpose_item(p.in[4] + offF, FF, DM, (bf16_t*)(wl + LW_D1), nullptr, 0, scr, r, lane); continue; } r -= I_D;
        if (r < I_IN) { transpose_item(p.in[6] + (size_t)l * DM * 2048, DM, 2048, (bf16_t*)(wl + LW_IN), p.in[5] + offN, 0, scr, r, lane); continue; } r -= I_IN;
        if (r < I_OUT) { transpose_item(p.in[21] + (size_t)l * DM * DM, DM, DM, (bf16_t*)(wl + LW_OUT), nullptr, 0, scr, r, lane); continue; } r -= I_OUT;
        if (r < I_G) { transpose_item(p.in[23] + offF, DM, FF, (bf16_t*)(wl + LW_GU2), p.in[22] + offN, 1, scr, r, lane); continue; } r -= I_G;
        if (r < I_G) { transpose_item(p.in[24] + offF, DM, FF, (bf16_t*)(wl + LW_GU2), p.in[22] + offN, 2, scr, r, lane); continue; } r -= I_G;
        transpose_item(p.in[25] + offF, FF, DM, (bf16_t*)(wl + LW_D2), nullptr, 0, scr, r, lane);
    }
    {
        const float* x = p.in[0]; bf16_t* XB = (bf16_t*)(p.ws + WS_XB); float* ssq0 = (float*)(p.ws + WS_SSQ);
        f32x4 cur[2][4];
#pragma unroll
        for (int rr = 0; rr < 2; ++rr)
#pragma unroll
            for (int j = 0; j < 4; ++j) cur[rr][j] = ((const f32x4*)(x + (size_t)(gw + rr * NGW) * DM) + lane)[64 * j];
        for (int row = gw; row < T_TOK; row += 2 * NGW) {
            f32x4 nxt[2][4];
            const bool more = row + 2 * NGW < T_TOK;
#pragma unroll
            for (int rr = 0; rr < 2; ++rr)
#pragma unroll
                for (int j = 0; j < 4; ++j) nxt[rr][j] = more ? ((const f32x4*)(x + (size_t)(row + (2 + rr) * NGW) * DM) + lane)[64 * j] : (f32x4){0.f, 0.f, 0.f, 0.f};
#pragma unroll
            for (int rr = 0; rr < 2; ++rr) {
                const int r2 = row + rr * NGW;
                u32x2* o = (u32x2*)(XB + (size_t)r2 * DM) + lane;
                float sq = 0.f;
#pragma unroll
                for (int j = 0; j < 4; ++j) { const f32x4 v = cur[rr][j]; sq += v[0] * v[0] + v[1] * v[1] + v[2] * v[2] + v[3] * v[3];
                    u32x2 q; q[0] = pk2(v[0], v[1]); q[1] = pk2(v[2], v[3]); o[64 * j] = q; }
                sq = wave_sum(sq);
                if (lane < 16) ssq0[(size_t)r2 * 16 + lane] = lane == 0 ? sq : 0.f;
            }
#pragma unroll
            for (int rr = 0; rr < 2; ++rr)
#pragma unroll
                for (int j = 0; j < 4; ++j) cur[rr][j] = nxt[rr][j];
        }
    }
    const int gt = l_bid() * 512 + tid, NT = GRID * 512;
    for (int i = gt; i < 2 * 4 * 128 * 128 / 4; i += NT) {
        const int l = i / (4 * 128 * 128 / 4), r = i % (4 * 128 * 128 / 4);
        const f32x4 v = ((const f32x4*)p.in[8])[i]; u32x2 q; q[0] = pk2(v[0], v[1]); q[1] = pk2(v[2], v[3]);
        ((u32x2*)(p.ws + WS_W + (size_t)l * LW_END + LW_SGU))[r] = q;
    }
    for (int i = gt; i < 2 * 16 * 1536; i += NT) {
        const int l = i / (16 * 1536), r = i % (16 * 1536), n = r / 1536, k = r % 1536;
        const float v = n < 8 ? p.in[15][((size_t)l * 1536 + k) * 8 + n] : p.in[17][((size_t)l * 1536 + k) * 8 + (n - 8)];
        ((bf16_t*)(p.ws + WS_W + (size_t)l * LW_END + LW_GT))[r] = (bf16_t)(pk2(v, 0.f) & 0xffffu);
    }
}

struct PrepPre { u32x2 x[12]; u32x4 wsl[2]; };
__device__ __forceinline__ void prep_issue(PrepPre& r, const bf16_t* ZXO, const bf16_t* WgT, size_t T0, int c, int hh, int g, int tq, int tid) {
    const int ch = hh * 128 + 4 * g;
#pragma unroll
    for (int k = 0; k < 12; ++k) {
        const int pos = c * 128 + 8 * tq + k - 2;
        const bf16_t* zb = ZXO + (T0 - 2) * 1024;
        if (pos >= 0 && pos < SEQ) r.x[k] = *(const u32x2*)(zb + (unsigned)((8 * tq + k) * 1024 + ch));
        else r.x[k] = (u32x2){0u, 0u};
    }
#pragma unroll
    for (int q = 0; q < 2; ++q) { const int ii = tid + 512 * q; if (ii < 768) { const int n = ii / 48, rem = ii % 48, part = rem >> 4, c16 = rem & 15;
        r.wsl[q] = *(const u32x4*)(WgT + (size_t)n * 1536 + part * 512 + hh * 128 + c16 * 8); } else r.wsl[q] = (u32x4){0u, 0u, 0u, 0u}; }
}
__device__ __forceinline__ void phase_prep(const Params& p, int l, unsigned char* shm) {
    const int tid = l_tid(), lane = tid & 63, w = tid >> 6, fr = lane & 15, fq = lane >> 4;
    const bf16_t* ZXO = (const bf16_t*)(p.ws + WS_ZXO);
    bf16_t* Qb = (bf16_t*)(p.ws + WS_Q); bf16_t* Kb = (bf16_t*)(p.ws + WS_K); bf16_t* Vb = (bf16_t*)(p.ws + WS_V); bf16_t* XCb = (bf16_t*)(p.ws + WS_XC);
    const float* conv_w = p.in[10] + (size_t)l * 5 * 512; const float* conv_b = p.in[11] + (size_t)l * 512;
    const float* wq = p.in[12] + (size_t)l * 128 * 16; const float* wk = p.in[13] + (size_t)l * 128 * 16; const float* wv = p.in[14] + (size_t)l * 128 * 16;
    const bf16_t* WgT = (const bf16_t*)(p.ws + WS_W + (size_t)l * LW_END + LW_GT);
    const float* gbf = p.in[16] + l * 8; const float* gbb = p.in[18] + l * 8;
    float* bvec = (float*)(p.ws + WS_BV); float* avec = (float*)(p.ws + WS_AV); float* cmvec = (float*)(p.ws + WS_CM); float* scal = (float*)(p.ws + WS_SC);
    constexpr int TP = 784;
    unsigned char* tile = shm; float* Gs = (float*)(shm + 128 * TP); unsigned char* wgl = shm + 128 * TP + 8192;
    float* wl = (float*)(shm + 128 * TP + 8192 + 16 * TP);
    for (int u = l_bid(); u < 256; u += GRID) {
        const int c = u & 63; const size_t T0 = (size_t)u * 128;
        const int g = tid & 31, tq = tid >> 5;
        for (int i = tid; i < 2304; i += 512) {
            f32x4 v;
            if (i < 640) v = ((const f32x4*)conv_w)[i]; else if (i < 768) v = ((const f32x4*)conv_b)[i - 640];
            else if (i < 1280) v = ((const f32x4*)wq)[i - 768]; else if (i < 1792) v = ((const f32x4*)wk)[i - 1280]; else v = ((const f32x4*)wv)[i - 1792];
            ((f32x4*)wl)[i] = v;
        }
        PrepPre r;
        prep_issue(r, ZXO, WgT, T0, c, 0, g, tq, tid);
        __syncthreads();
        f32x4 gacc = {0.f, 0.f, 0.f, 0.f};
        for (int hh = 0; hh < 4; ++hh) {
            int tqv = tq, gv = g; asm volatile("" : "+v"(tqv), "+v"(gv));
            const int ch = hh * 128 + 4 * gv;
            f32x4 cw[5];
#pragma unroll
            for (int j = 0; j < 5; ++j) cw[j] = *(const f32x4*)(wl + j * 512 + ch);
            const f32x4 cb = *(const f32x4*)(wl + 2560 + ch);
            const volatile f32x4* wqv = (const volatile f32x4*)(wl + 3072 + (hh * 32 + gv) * 16);
            bf16_t* xb0 = XCb + T0 * 512;
#pragma unroll
            for (int i = 0; i < 8; ++i) {
                const int t = 8 * tqv + i;
                f32x4 xs[5];
#pragma unroll
                for (int j = 0; j < 5; ++j) { const u32x2 rr = r.x[i + j]; xs[j] = (f32x4){bflo(rr[0]), bfhi(rr[0]), bflo(rr[1]), bfhi(rr[1])}; }
                f32x4 a = cb;
#pragma unroll
                for (int j = 0; j < 5; ++j) a += cw[j] * xs[j];
                f32x4 xc;
#pragma unroll
                for (int e = 0; e < 4; ++e) xc[e] = a[e] * __builtin_amdgcn_rcpf(1.f + __expf(-a[e]));
                f32x4 q, k, v;
                { const f32x4 w0 = wqv[0], w1 = wqv[1], w2 = wqv[2], w3 = wqv[3]; q = xc[0] * w0 + xc[1] * w1 + xc[2] * w2 + xc[3] * w3; }
                { const f32x4 w0 = wqv[512], w1 = wqv[513], w2 = wqv[514], w3 = wqv[515]; k = (xc[0] * w0 + xc[1] * w1 + xc[2] * w2 + xc[3] * w3) * 0.08838834764831845f; }
                { const f32x4 w0 = wqv[1024], w1 = wqv[1025], w2 = wqv[1026], w3 = wqv[1027]; v = xs[2][0] * w0 + xs[2][1] * w1 + xs[2][2] * w2 + xs[2][3] * w3; }
                u32x2 qp, kp, vp;
                qp[0] = pk2(q[0], q[1]); qp[1] = pk2(q[2], q[3]); kp[0] = pk2(k[0], k[1]); kp[1] = pk2(k[2], k[3]);
                vp[0] = pk2(v[0], v[1]); vp[1] = pk2(v[2], v[3]);
                { u32x2 xp; xp[0] = pk2(xc[0], xc[1]); xp[1] = pk2(xc[2], xc[3]); *(u32x2*)(xb0 + (unsigned)((8 * tqv + i) * 512 + ch)) = xp; }
                unsigned char* tr = tile + t * TP + gv * 8;
                *(u32x2*)(tr) = qp; *(u32x2*)(tr + 256) = kp; *(u32x2*)(tr + 512) = vp;
            }
#pragma unroll
            for (int q = 0; q < 2; ++q) { const int ii = tid + 512 * q; if (ii < 768) { const int n = ii / 48, rem = ii % 48, part = rem >> 4, c16 = rem & 15;
                *(u32x4*)(wgl + n * TP + part * 256 + c16 * 16) = r.wsl[q]; } }
            if (hh < 3) prep_issue(r, ZXO, WgT, T0, c, hh + 1, gv, tqv, tid);
            __syncthreads();
#pragma unroll
            for (int kk = 0; kk < 12; ++kk) {
                const bf16x8 a = *(const bf16x8*)(tile + (16 * w + fr) * TP + kk * 64 + fq * 16);
                const bf16x8 b = *(const bf16x8*)(wgl + fr * TP + kk * 64 + fq * 16);
                gacc = __builtin_amdgcn_mfma_f32_16x16x32_bf16(b, a, gacc, 0, 0, 0);
            }
            __builtin_amdgcn_sched_barrier(0);
#pragma unroll
            for (int i = 0; i < 12; ++i) { if ((i & 3) == 0) __builtin_amdgcn_sched_barrier(0);
                const int rem = tid + 512 * (i & 3), row = rem >> 4, cc = rem & 15;
                const u32x4 vv = *(const u32x4*)(tile + row * TP + (i >> 2) * 256 + cc * 16);
                bf16_t* dst = ((i >> 2) == 0 ? Qb : (i >> 2) == 1 ? Kb : Vb) + T0 * 512 + hh * 128;
                *(u32x4*)(dst + (unsigned)(row * 512 + cc * 8)) = vv; }
            __syncthreads();
        }
        { const f32x4 bias = (fq < 2) ? *(const f32x4*)(gbf + fq * 4) : *(const f32x4*)(gbb + (fq - 2) * 4);
          *(f32x4*)(Gs + (16 * w + fr) * 16 + fq * 4) = gacc + bias; }
        __syncthreads();
        {
            const int dir = w >> 2, hs = w & 3;
            const int e0 = 2 * lane, e1 = e0 + 1, p0 = dir ? 127 - e0 : e0, p1 = dir ? 127 - e1 : e1;
            const float ig0 = Gs[p0 * 16 + dir * 8 + hs], ig1 = Gs[p1 * 16 + dir * 8 + hs];
            const float lf0 = logsig(Gs[p0 * 16 + dir * 8 + 4 + hs]), lf1 = logsig(Gs[p1 * 16 + dir * 8 + 4 + hs]);
            const float s1 = lf0 + lf1; float incl = s1;
#pragma unroll
            for (int off = 1; off < 64; off <<= 1) { const float t = __shfl_up(incl, off); if (lane >= off) incl += t; }
            const float excl = incl - s1, b0 = excl + lf0, b1 = excl + s1, btot = __shfl(incl, 63);
            const float a0 = ig0 - b0, a1 = ig1 - b1, c1 = fmaxf(a0, a1); float mx = c1;
#pragma unroll
            for (int off = 1; off < 64; off <<= 1) { const float t = __shfl_up(mx, off); if (lane >= off) mx = fmaxf(mx, t); }
            float ex = __shfl_up(mx, 1); if (lane == 0) ex = -INFINITY;
            const float cm0 = fmaxf(ex, a0), cm1 = fmaxf(ex, c1), amax = __shfl(mx, 63);
            const size_t idx = ((size_t)(u * 4 + hs)) * 2 + dir;
            bvec[idx * 128 + p0] = b0; bvec[idx * 128 + p1] = b1; avec[idx * 128 + p0] = a0; avec[idx * 128 + p1] = a1;
            cmvec[idx * 128 + p0] = cm0; cmvec[idx * 128 + p1] = cm1;
            if (lane == 0) { scal[idx * 2] = btot; scal[idx * 2 + 1] = amax; }
        }
        __syncthreads();
    }
}

__device__ __forceinline__ void load_tile_T(unsigned char* dst, const bf16_t* src, size_t gp, int tid) {
    const int sp = tid & 63, cg0 = tid >> 6;
#pragma unroll
    for (int it = 0; it < 2; ++it) {
        const int chunk = cg0 + 8 * it;
        const bf16_t* sp0 = src + (size_t)(2 * sp) * gp + chunk * 8;
        const u32x4 r0 = *(const u32x4*)sp0, r1 = *(const u32x4*)(sp0 + gp);
#pragma unroll
        for (int e = 0; e < 8; ++e) {
            const unsigned w0 = r0[e >> 1], w1 = r1[e >> 1];
            const unsigned lo = (e & 1) ? (w0 >> 16) : (w0 & 0xffffu), hi = (e & 1) ? (w1 & 0xffff0000u) : (w1 << 16);
            *(unsigned*)(dst + (chunk * 8 + e) * MP + sp * 4) = lo | hi;
        }
    }
}

struct StPre { u32x4 k[2][2], v[2][2]; float a; };
__device__ __forceinline__ void state_issue(StPre& r, const Params& p, int unit, int tid) {
    const int u = unit >> 2, hh = unit & 3; const size_t T0 = (size_t)u * 128;
    const bf16_t* Kb = (const bf16_t*)(p.ws + WS_K); const bf16_t* Vb = (const bf16_t*)(p.ws + WS_V);
    const float* avec = (const float*)(p.ws + WS_AV); const float* scal = (const float*)(p.ws + WS_SC);
    const int sp = tid & 63, cg0 = tid >> 6;
#pragma unroll
    for (int it = 0; it < 2; ++it) { const size_t o = (T0 + 2 * sp) * 512 + hh * 128 + (cg0 + 8 * it) * 8;
        r.k[it][0] = *(const u32x4*)(Kb + o); r.k[it][1] = *(const u32x4*)(Kb + o + 512);
        r.v[it][0] = *(const u32x4*)(Vb + o); r.v[it][1] = *(const u32x4*)(Vb + o + 512); }
    const int t2 = tid & 255, dir = t2 >> 7, s = t2 & 127; const size_t idx = (size_t)unit * 2 + dir;
    r.a = avec[idx * 128 + s] - scal[idx * 2 + 1];
}
__device__ __forceinline__ void phase_state(const Params& p, unsigned char* shm) {
    const int tid = l_tid(), lane = tid & 63, w = tid >> 6, fr = lane & 15, fq = lane >> 4;
    bf16_t* CS = (bf16_t*)(p.ws + WS_CS); float* DN = (float*)(p.ws + WS_DN);
    unsigned char* VT = shm; unsigned char* KTF = shm + MBUF; unsigned char* KTB = shm + 2 * MBUF; float* wk = (float*)(shm + 4 * MBUF);
    int unit = 4 * l_bid(); const int uend = unit + 4;
    StPre r;
    if (unit < 1024) state_issue(r, p, unit, tid);
    for (; unit < uend && unit < 1024; ++unit) {
        if (tid < 256) wk[tid] = __expf(r.a);
        __syncthreads();
        {
            const int sp = tid & 63, cg0 = tid >> 6;
            const float wf0 = wk[2 * sp], wf1 = wk[2 * sp + 1], wb0 = wk[128 + 2 * sp], wb1 = wk[128 + 2 * sp + 1];
#pragma unroll
            for (int it = 0; it < 2; ++it) {
                const int chunk = cg0 + 8 * it;
#pragma unroll
                for (int e = 0; e < 8; ++e) {
                    const unsigned w0 = r.v[it][0][e >> 1], w1 = r.v[it][1][e >> 1];
                    const unsigned lo = (e & 1) ? (w0 >> 16) : (w0 & 0xffffu), hi = (e & 1) ? (w1 & 0xffff0000u) : (w1 << 16);
                    *(unsigned*)(VT + (chunk * 8 + e) * MP + sp * 4) = lo | hi;
                    const float k0 = bfel(r.k[it][0], e), k1 = bfel(r.k[it][1], e);
                    *(unsigned*)(KTF + (chunk * 8 + e) * MP + sp * 4) = pk2(k0 * wf0, k1 * wf1);
                    *(unsigned*)(KTB + (chunk * 8 + e) * MP + sp * 4) = pk2(k0 * wb0, k1 * wb1);
                }
            }
        }
        __syncthreads();
        if (unit + 1 < uend) state_issue(r, p, unit + 1, tid);
#pragma unroll
        for (int dir = 0; dir < 2; ++dir) {
            f32x4 acc[8]; zero8(acc);
            wave_gemm128(acc, VT + 16 * w * MP, dir ? KTB : KTF, fr, fq);
            bf16_t* dst = CS + ((size_t)unit * 2 + dir) * 16384 + (16 * w + fr) * 128 + 4 * fq;
#pragma unroll
            for (int n = 0; n < 8; ++n) { u32x2 o; o[0] = pk2(acc[n][0], acc[n][1]); o[1] = pk2(acc[n][2], acc[n][3]); *(u32x2*)(dst + n * 16) = o; }
        }
        {
            const int k = tid >> 2, part = tid & 3;
#pragma unroll
            for (int dir = 0; dir < 2; ++dir) {
                const unsigned char* base = (dir ? KTB : KTF) + k * MP + part * 64;
                float sm = 0.f;
#pragma unroll
                for (int i = 0; i < 4; ++i) { const u32x4 q = *(const u32x4*)(base + i * 16);
#pragma unroll
                    for (int e = 0; e < 4; ++e) sm += bflo(q[e]) + bfhi(q[e]); }
                sm += __shfl_xor(sm, 1); sm += __shfl_xor(sm, 2);
                if (part == 0) DN[((size_t)unit * 2 + dir) * 128 + k] = sm;
            }
        }
        __syncthreads();
    }
}

struct SgPre { u32x4 v[2][2]; };
__device__ __forceinline__ void sgu_issue(SgPre& r, const Params& p, int unit, int tid) {
    const int u = unit >> 2, hh = unit & 3; const size_t T0 = (size_t)u * 128;
    const bf16_t* ZUV = (const bf16_t*)(p.ws + WS_ZUV);
    const int sp = tid & 63, cg0 = tid >> 6;
#pragma unroll
    for (int it = 0; it < 2; ++it) { const size_t o = (T0 + 2 * sp) * 1024 + 512 + hh * 128 + (cg0 + 8 * it) * 8;
        r.v[it][0] = *(const u32x4*)(ZUV + o); r.v[it][1] = *(const u32x4*)(ZUV + o + 1024); }
}
__device__ __forceinline__ void phase_sgu(const Params& p, int l, unsigned char* shm) {
    const int tid = l_tid(), lane = tid & 63, w = tid >> 6, fr = lane & 15, fq = lane >> 4;
    bf16_t* ZUV = (bf16_t*)(p.ws + WS_ZUV);
    unsigned char* WS = shm; unsigned char* VHT = shm + MBUF; float* part = (float*)(shm + 4 * MBUF);
    const int G = GRID; int unit = l_bid();
    if (unit >= 1024) return;
    const int hh = unit & 3;
    const bf16_t* Wsb = (const bf16_t*)(p.ws + WS_W + (size_t)l * LW_END + LW_SGU);
    const float* gnb = p.in[7] + (size_t)l * 512; const float* bsb = p.in[9] + (size_t)l * 512;
    SgPre r;
    sgu_issue(r, p, unit, tid);
    int staged = -1;
    for (; unit < 1024; unit += G) {
        const int u = unit >> 2, hu = unit & 3; const size_t T0 = (size_t)u * 128;
        if (staged != hu) { load_tile(WS, Wsb + (size_t)hu * 128 * 128, 128, tid); staged = hu; }
        const int sp = tid & 63, cg0 = tid >> 6;
        {
            float s0 = 0.f, q0 = 0.f, s1 = 0.f, q1 = 0.f;
#pragma unroll
            for (int it = 0; it < 2; ++it)
#pragma unroll
                for (int e = 0; e < 4; ++e) { const float a0 = bflo(r.v[it][0][e]), a1 = bfhi(r.v[it][0][e]), b0 = bflo(r.v[it][1][e]), b1 = bfhi(r.v[it][1][e]);
                    s0 += a0 + a1; q0 += a0 * a0 + a1 * a1; s1 += b0 + b1; q1 += b0 * b0 + b1 * b1; }
            *(f32x4*)(part + (cg0 * 128 + 2 * sp) * 2) = (f32x4){s0, q0, s1, q1};
        }
        __syncthreads();
        {
            float s0 = 0.f, q0 = 0.f, s1 = 0.f, q1 = 0.f;
#pragma unroll
            for (int ww = 0; ww < 8; ++ww) { const f32x4 t = *(const f32x4*)(part + (ww * 128 + 2 * sp) * 2); s0 += t[0]; q0 += t[1]; s1 += t[2]; q1 += t[3]; }
            const float mu0 = s0 * (1.f / 128.f), mu1 = s1 * (1.f / 128.f);
            const float rs0 = rsqrtf(fmaxf(q0 * (1.f / 128.f) - mu0 * mu0, 0.f) + EPSN), rs1 = rsqrtf(fmaxf(q1 * (1.f / 128.f) - mu1 * mu1, 0.f) + EPSN);
            const float* gn = gnb + hu * 128;
#pragma unroll
            for (int it = 0; it < 2; ++it) {
                const int chunk = cg0 + 8 * it;
                const f32x4 g0 = *(const f32x4*)(gn + chunk * 8), g1 = *(const f32x4*)(gn + chunk * 8 + 4);
#pragma unroll
                for (int e = 0; e < 8; ++e) {
                    const float gg = e < 4 ? g0[e & 3] : g1[e & 3];
                    const float a = (bfel(r.v[it][0], e) - mu0) * rs0 * gg, b = (bfel(r.v[it][1], e) - mu1) * rs1 * gg;
                    *(unsigned*)(VHT + (chunk * 8 + e) * MP + sp * 4) = pk2(a, b);
                }
            }
        }
        __syncthreads();
        if (unit + G < 1024) sgu_issue(r, p, unit + G, tid);
        const int pr = 16 * w + fr; const float bias = bsb[hu * 128 + pr];
        bf16_t* up = ZUV + (T0 + pr) * 1024 + hu * 128 + 4 * fq;
        u32x2 uu[8];
#pragma unroll
        for (int n = 0; n < 8; ++n) uu[n] = *(const u32x2*)(up + n * 16);
        f32x4 acc[8]; zero8(acc);
        wave_gemm128(acc, WS + 16 * w * MP, VHT, fr, fq);
        {
#pragma unroll
            for (int n = 0; n < 8; ++n) {
                u32x2 o; o[0] = pk2(bflo(uu[n][0]) * (acc[n][0] + bias), bfhi(uu[n][0]) * (acc[n][1] + bias));
                o[1] = pk2(bflo(uu[n][1]) * (acc[n][2] + bias), bfhi(uu[n][1]) * (acc[n][3] + bias));
                *(u32x2*)(up + n * 16) = o;
            }
        }
        __syncthreads();
    }
}

__device__ __forceinline__ void phase_scan_sgu(const Params& p, int l, unsigned char* shm) {
    static_assert(GRID * 512 == 32 * 4096 && 1024 / GRID == 4, "one scan item per thread, four SGU units per block");
    const int tid = l_tid(), lane = tid & 63, w = tid >> 6, fr = lane & 15, fq = lane >> 4;
    bf16_t* ZUV = (bf16_t*)(p.ws + WS_ZUV);
    unsigned char* WS = shm; unsigned char* VHT = shm + MBUF; float* part = (float*)(shm + 4 * MBUF);
    const int G = GRID; int unit = l_bid();
    if (unit >= 1024) return;
    const int hh = unit & 3;
    const bf16_t* Wsb = (const bf16_t*)(p.ws + WS_W + (size_t)l * LW_END + LW_SGU);
    const float* gnb = p.in[7] + (size_t)l * 512; const float* bsb = p.in[9] + (size_t)l * 512;
    SgPre r;
    sgu_issue(r, p, unit, tid);
    int staged = -1;
    bf16_t* CS = (bf16_t*)(p.ws + WS_CS); float* DN = (float*)(p.ws + WS_DN);
    const float* scal = (const float*)(p.ws + WS_SC); float* mst = (float*)(p.ws + WS_MS);
    const int chain = l_bid() >> 3, q4 = (l_bid() & 7) * 512 + tid, sb = chain >> 3, shh = (chain >> 1) & 3, sdir = chain & 1;
    const bool has_n = q4 < 128;
    float C0 = 0.f, C1 = 0.f, C2 = 0.f, C3 = 0.f, nn = 0.f;
    float* cf1 = (float*)(shm + 2 * MBUF); float* cf2 = cf1 + 64; float* cmp = cf1 + 128;
    if (tid < 64) { const int st = tid, c = sdir ? 63 - st : st; const size_t idx = ((size_t)((sb * 64 + c) * 4 + shh)) * 2 + sdir; cf1[st] = scal[idx * 2]; cf2[st] = scal[idx * 2 + 1]; }
    __syncthreads();
    if (tid == 0) { float sm = 0.f;
#pragma unroll 8
        for (int st = 0; st < 64; ++st) { const float bt = cf1[st], am = cf2[st], mm = fmaxf(sm, am);
            cmp[st] = sm; cf1[st] = __expf(sm - mm); cf2[st] = __expf(am - mm); sm = bt + mm; } }
    __syncthreads();
    int kb = 0;
    for (; unit < 1024; unit += G, ++kb) {
        u32x2 sd[8]; float sdn[8];
#define SCAN_ISSUE(ST0) _Pragma("unroll") for (int jj = 0; jj < 8; ++jj) { const int st = (ST0) + jj, c = sdir ? 63 - st : st; const size_t idx = ((size_t)((sb * 64 + c) * 4 + shh)) * 2 + sdir; \
            sd[jj] = *(const u32x2*)(CS + idx * 16384 + q4 * 4); sdn[jj] = has_n ? DN[idx * 128 + q4] : 0.f; }
#define SCAN_CONSUME(ST0) _Pragma("unroll") for (int jj = 0; jj < 8; ++jj) { const int st = (ST0) + jj, c = sdir ? 63 - st : st; const size_t idx = ((size_t)((sb * 64 + c) * 4 + shh)) * 2 + sdir; \
            u32x2 o; o[0] = pk2(C0, C1); o[1] = pk2(C2, C3); *(u32x2*)(CS + idx * 16384 + q4 * 4) = o; \
            if (has_n) DN[idx * 128 + q4] = nn; \
            if (q4 == 0) mst[idx] = cmp[st]; \
            const float f1 = cf1[st], f2 = cf2[st]; \
            C0 = f1 * C0 + f2 * bflo(sd[jj][0]); C1 = f1 * C1 + f2 * bfhi(sd[jj][0]); C2 = f1 * C2 + f2 * bflo(sd[jj][1]); C3 = f1 * C3 + f2 * bfhi(sd[jj][1]); \
            nn = f1 * nn + f2 * sdn[jj]; }
        SCAN_ISSUE(16 * kb)
        const int u = unit >> 2, hu = unit & 3; const size_t T0 = (size_t)u * 128;
        if (staged != hu) { load_tile(WS, Wsb + (size_t)hu * 128 * 128, 128, tid); staged = hu; }
        const int sp = tid & 63, cg0 = tid >> 6;
        {
            float s0 = 0.f, q0 = 0.f, s1 = 0.f, q1 = 0.f;
#pragma unroll
            for (int it = 0; it < 2; ++it)
#pragma unroll
                for (int e = 0; e < 4; ++e) { const float a0 = bflo(r.v[it][0][e]), a1 = bfhi(r.v[it][0][e]), b0 = bflo(r.v[it][1][e]), b1 = bfhi(r.v[it][1][e]);
                    s0 += a0 + a1; q0 += a0 * a0 + a1 * a1; s1 += b0 + b1; q1 += b0 * b0 + b1 * b1; }
            *(f32x4*)(part + (cg0 * 128 + 2 * sp) * 2) = (f32x4){s0, q0, s1, q1};
        }
        __syncthreads();
        {
            float s0 = 0.f, q0 = 0.f, s1 = 0.f, q1 = 0.f;
#pragma unroll
            for (int ww = 0; ww < 8; ++ww) { const f32x4 t = *(const f32x4*)(part + (ww * 128 + 2 * sp) * 2); s0 += t[0]; q0 += t[1]; s1 += t[2]; q1 += t[3]; }
            const float mu0 = s0 * (1.f / 128.f), mu1 = s1 * (1.f / 128.f);
            const float rs0 = rsqrtf(fmaxf(q0 * (1.f / 128.f) - mu0 * mu0, 0.f) + EPSN), rs1 = rsqrtf(fmaxf(q1 * (1.f / 128.f) - mu1 * mu1, 0.f) + EPSN);
            const float* gn = gnb + hu * 128;
#pragma unroll
            for (int it = 0; it < 2; ++it) {
                const int chunk = cg0 + 8 * it;
                const f32x4 g0 = *(const f32x4*)(gn + chunk * 8), g1 = *(const f32x4*)(gn + chunk * 8 + 4);
#pragma unroll
                for (int e = 0; e < 8; ++e) {
                    const float gg = e < 4 ? g0[e & 3] : g1[e & 3];
                    const float a = (bfel(r.v[it][0], e) - mu0) * rs0 * gg, b = (bfel(r.v[it][1], e) - mu1) * rs1 * gg;
                    *(unsigned*)(VHT + (chunk * 8 + e) * MP + sp * 4) = pk2(a, b);
                }
            }
        }
        __syncthreads();
        SCAN_CONSUME(16 * kb)
        SCAN_ISSUE(16 * kb + 8)
        if (unit + G < 1024) sgu_issue(r, p, unit + G, tid);
        const int pr = 16 * w + fr; const float bias = bsb[hu * 128 + pr];
        bf16_t* up = ZUV + (T0 + pr) * 1024 + hu * 128 + 4 * fq;
        u32x2 uu[8];
#pragma unroll
        for (int n = 0; n < 8; ++n) uu[n] = *(const u32x2*)(up + n * 16);
        f32x4 acc[8]; zero8(acc);
        wave_gemm128(acc, WS + 16 * w * MP, VHT, fr, fq);
        {
#pragma unroll
            for (int n = 0; n < 8; ++n) {
                u32x2 o; o[0] = pk2(bflo(uu[n][0]) * (acc[n][0] + bias), bfhi(uu[n][0]) * (acc[n][1] + bias));
                o[1] = pk2(bflo(uu[n][1]) * (acc[n][2] + bias), bfhi(uu[n][1]) * (acc[n][3] + bias));
                *(u32x2*)(up + n * 16) = o;
            }
        }
        __syncthreads();
        SCAN_CONSUME(16 * kb + 8)
#undef SCAN_ISSUE
#undef SCAN_CONSUME
    }
}

__device__ __forceinline__ void phase_scan(const Params& p) {
    const int gt = l_bid() * 512 + l_tid(), NT = GRID * 512;
    bf16_t* CS = (bf16_t*)(p.ws + WS_CS); float* DN = (float*)(p.ws + WS_DN);
    const float* scal = (const float*)(p.ws + WS_SC); float* mst = (float*)(p.ws + WS_MS);
    for (int item = gt; item < 32 * 4096; item += NT) {
        const int chain = item >> 12, q4 = item & 4095, b = chain >> 3, hh = (chain >> 1) & 3, dir = chain & 1;
        float m = 0.f, C0 = 0.f, C1 = 0.f, C2 = 0.f, C3 = 0.f;
        for (int s0 = 0; s0 < 64; s0 += 8) {
            u32x2 d[8]; float bt[8], am[8];
#pragma unroll
            for (int j = 0; j < 8; ++j) { const int st = s0 + j, c = dir ? 63 - st : st; const size_t idx = ((size_t)((b * 64 + c) * 4 + hh)) * 2 + dir;
                d[j] = *(const u32x2*)(CS + idx * 16384 + q4 * 4); bt[j] = scal[idx * 2]; am[j] = scal[idx * 2 + 1]; }
#pragma unroll
            for (int j = 0; j < 8; ++j) { const int st = s0 + j, c = dir ? 63 - st : st; const size_t idx = ((size_t)((b * 64 + c) * 4 + hh)) * 2 + dir;
                u32x2 o; o[0] = pk2(C0, C1); o[1] = pk2(C2, C3); *(u32x2*)(CS + idx * 16384 + q4 * 4) = o;
                if (q4 == 0) mst[idx] = m;
                const float mm = fmaxf(m, am[j]), f1 = __expf(m - mm), f2 = __expf(am[j] - mm);
                C0 = f1 * C0 + f2 * bflo(d[j][0]); C1 = f1 * C1 + f2 * bfhi(d[j][0]); C2 = f1 * C2 + f2 * bflo(d[j][1]); C3 = f1 * C3 + f2 * bfhi(d[j][1]);
                m = bt[j] + mm; }
        }
    }
    for (int item = gt; item < 32 * 128; item += NT) {
        const int chain = item >> 7, k = item & 127, b = chain >> 3, hh = (chain >> 1) & 3, dir = chain & 1;
        float m = 0.f, n = 0.f;
        for (int s0 = 0; s0 < 64; s0 += 8) {
            float d[8], bt[8], am[8];
#pragma unroll
            for (int j = 0; j < 8; ++j) { const int st = s0 + j, c = dir ? 63 - st : st; const size_t idx = ((size_t)((b * 64 + c) * 4 + hh)) * 2 + dir;
                d[j] = DN[idx * 128 + k]; bt[j] = scal[idx * 2]; am[j] = scal[idx * 2 + 1]; }
#pragma unroll
            for (int j = 0; j < 8; ++j) { const int st = s0 + j, c = dir ? 63 - st : st; const size_t idx = ((size_t)((b * 64 + c) * 4 + hh)) * 2 + dir;
                DN[idx * 128 + k] = n;
                const float mm = fmaxf(m, am[j]), f1 = __expf(m - mm), f2 = __expf(am[j] - mm);
                n = f1 * n + f2 * d[j]; m = bt[j] + mm; }
        }
    }
}

struct QKPre { u32x4 q[4], k[4], cf[4], v[2][2]; float va, vM, vb, vn, m; };
__device__ __forceinline__ void issue_qk(QKPre& r, const Params& p, int unit, int tid) {
    const int u = unit >> 2, hh = unit & 3; const size_t ub = (size_t)u * 128 * 512 + hh * 128;
    const bf16_t* Qb = (const bf16_t*)(p.ws + WS_Q) + ub; const bf16_t* Kb = (const bf16_t*)(p.ws + WS_K) + ub; const bf16_t* Vb = (const bf16_t*)(p.ws + WS_V) + ub;
    const bf16_t* Cf = (const bf16_t*)(p.ws + WS_CS) + (size_t)unit * 2 * 16384;
#pragma unroll
    for (int i = 0; i < 4; ++i) { const int id = tid + 512 * i, row = id >> 4, cc = id & 15;
        r.q[i] = *(const u32x4*)(Qb + row * 512 + cc * 8); r.k[i] = *(const u32x4*)(Kb + row * 512 + cc * 8); r.cf[i] = *(const u32x4*)(Cf + row * 128 + cc * 8); }
    const int sp = tid & 63, cg0 = tid >> 6;
#pragma unroll
    for (int it = 0; it < 2; ++it) { const bf16_t* vp = Vb + (2 * sp) * 512 + (cg0 + 8 * it) * 8; r.v[it][0] = *(const u32x4*)vp; r.v[it][1] = *(const u32x4*)(vp + 512); }
    const int t2 = tid & 255; const int vo = unit * 256 + t2;
    const float m = ((const float*)(p.ws + WS_MS))[unit * 2 + (t2 >> 7)];
    r.va = ((const float*)(p.ws + WS_AV))[vo]; r.vM = fmaxf(m, ((const float*)(p.ws + WS_CM))[vo]); r.vb = ((const float*)(p.ws + WS_BV))[vo]; r.vn = ((const float*)(p.ws + WS_DN))[vo]; r.m = m;
}
__device__ __forceinline__ void unit_out(const Params& p, int l, unsigned char* shm, int unit, QKPre& pre, int next) {
    const int tid = l_tid(), lane = tid & 63, w = tid >> 6, fr = lane & 15, fq = lane >> 4;
    const int u = unit >> 2, hh = unit & 3; const size_t T0 = (size_t)u * 128;
    const bf16_t* Qb = (const bf16_t*)(p.ws + WS_Q); const bf16_t* Kb = (const bf16_t*)(p.ws + WS_K); const bf16_t* Vb = (const bf16_t*)(p.ws + WS_V);
    const bf16_t* XCb = (const bf16_t*)(p.ws + WS_XC); const bf16_t* ZXO = (const bf16_t*)(p.ws + WS_ZXO); bf16_t* ZUV = (bf16_t*)(p.ws + WS_ZUV);
    const bf16_t* CS = (const bf16_t*)(p.ws + WS_CS); const float* DN = (const float*)(p.ws + WS_DN);
    const float* bvec = (const float*)(p.ws + WS_BV); const float* avec = (const float*)(p.ws + WS_AV); const float* cmvec = (const float*)(p.ws + WS_CM);
    const float* mst = (const float*)(p.ws + WS_MS);
    const float* mhn = p.in[19] + (size_t)l * 512; const float* skip = p.in[20] + (size_t)l * 512;
    unsigned char* QS = shm; unsigned char* KS = shm + MBUF; unsigned char* VT = shm + 2 * MBUF; unsigned char* CX = shm + 3 * MBUF;
    float* vec = (float*)(shm + 4 * MBUF);
#pragma unroll
    for (int i = 0; i < 4; ++i) { const int id = tid + 512 * i, row = id >> 4, cc = id & 15; *(u32x4*)(QS + row * MP + cc * 16) = pre.q[i]; *(u32x4*)(KS + row * MP + cc * 16) = pre.k[i]; }
#pragma unroll
    for (int i = 0; i < 4; ++i) { const int id = tid + 512 * i, row = id >> 4, cc = id & 15; *(u32x4*)(CX + row * MP + cc * 16) = pre.cf[i]; }
    {
        const int sp = tid & 63, cg0 = tid >> 6;
#pragma unroll
        for (int it = 0; it < 2; ++it)
#pragma unroll
            for (int e = 0; e < 8; ++e) {
                const unsigned w0 = pre.v[it][0][e >> 1], w1 = pre.v[it][1][e >> 1];
                const unsigned lo = (e & 1) ? (w0 >> 16) : (w0 & 0xffffu), hi = (e & 1) ? (w1 & 0xffff0000u) : (w1 << 16);
                *(unsigned*)(VT + ((cg0 + 8 * it) * 8 + e) * MP + sp * 4) = lo | hi;
            }
    }
    if (tid < 256) { const int dir = tid >> 7, s = tid & 127;
        vec[dir * 128 + s] = pre.va; vec[256 + dir * 128 + s] = pre.vM; vec[512 + dir * 128 + s] = pre.vb; vec[768 + dir * 128 + s] = pre.vn;
        if (s == 0) vec[1280 + dir] = pre.m; }
    __syncthreads();
    {
        const int j = tid >> 2, part = tid & 3;
        const unsigned char* qp = QS + j * MP + part * 64;
        float df = 0.f, db = 0.f;
#pragma unroll
        for (int i = 0; i < 4; ++i) { const u32x4 r = *(const u32x4*)(qp + i * 16);
#pragma unroll
            for (int e = 0; e < 4; ++e) { const int k = part * 32 + i * 8 + 2 * e; const float q0 = bflo(r[e]), q1 = bfhi(r[e]);
                df += q0 * vec[768 + k] + q1 * vec[768 + k + 1]; db += q0 * vec[896 + k] + q1 * vec[896 + k + 1]; } }
        df += __shfl_xor(df, 1); df += __shfl_xor(df, 2); db += __shfl_xor(db, 1); db += __shfl_xor(db, 2);
        if (part == 0) { vec[1024 + j] = df; vec[1152 + j] = db; }
    }
    u32x4 cbr[4];
#pragma unroll
    for (int i = 0; i < 4; ++i) { const int id = tid + 512 * i, row = id >> 4, cc = id & 15; cbr[i] = *(const u32x4*)(CS + ((size_t)unit * 2 + 1) * 16384 + row * 128 + cc * 8); }
    f32x4 S[8]; zero8(S);
    wave_gemm128(S, QS + 16 * w * MP, KS, fr, fq);
    __syncthreads();
    const int j = 16 * w + fr;
    float scf, scb;
    {
        const float Mfj = vec[256 + j], Mbj = vec[384 + j], bfj = vec[512 + j], bbj = vec[640 + j], nqfj = vec[1024 + j], nqbj = vec[1152 + j], mf = vec[1280], mb = vec[1281];
        f32x4 Sb[8]; float rf = 0.f, rb = 0.f;
#pragma unroll
        for (int n = 0; n < 8; ++n) {
            const int s0 = n * 16 + 4 * fq;
            const f32x4 af4 = *(const f32x4*)(vec + s0), ab4 = *(const f32x4*)(vec + 128 + s0);
#pragma unroll
            for (int i = 0; i < 4; ++i) {
                const int s = s0 + i;
                const float wf = (s <= j) ? __expf(af4[i] - Mfj) : 0.f, wb = (s >= j) ? __expf(ab4[i] - Mbj) : 0.f;
                const float sv = S[n][i];
                S[n][i] = sv * wf; Sb[n][i] = sv * wb; rf += sv * wf; rb += sv * wb;
            }
        }
        rf += __shfl_xor(rf, 16); rf += __shfl_xor(rf, 32); rb += __shfl_xor(rb, 16); rb += __shfl_xor(rb, 32);
        const float wif = __expf(mf - Mfj), wib = __expf(mb - Mbj);
        const float nqf = wif * nqfj + rf, nqb = wib * nqbj + rb;
        const float invf = 1.f / fmaxf(fabsf(nqf), __expf(-(bfj + Mfj))), invb = 1.f / fmaxf(fabsf(nqb), __expf(-(bbj + Mbj)));
        scf = wif * invf; scb = wib * invb;
#pragma unroll
        for (int n = 0; n < 8; ++n) {
            const f32x4 P = S[n] * invf + Sb[n] * invb;
            u32x2 o; o[0] = pk2(P[0], P[1]); o[1] = pk2(P[2], P[3]);
            *(u32x2*)(KS + j * MP + (n * 16 + 4 * fq) * 2) = o;
        }
    }
    f32x4 aF[8], aI[8]; zero8(aF); zero8(aI);
    wave_gemm128(aF, QS + 16 * w * MP, CX, fr, fq);
    wave_gemm128(aI, KS + 16 * w * MP, VT, fr, fq);
    __syncthreads();
#pragma unroll
    for (int i = 0; i < 4; ++i) { const int id = tid + 512 * i, row = id >> 4, cc = id & 15; *(u32x4*)(CX + row * MP + cc * 16) = cbr[i]; }
    u32x2 xcr[8], ogr[8];
#pragma unroll
    for (int n = 0; n < 8; ++n) { const int ch = hh * 128 + n * 16 + 4 * fq;
        xcr[n] = *(const u32x2*)(XCb + (T0 + j) * 512 + ch); ogr[n] = *(const u32x2*)(ZXO + (T0 + j) * 1024 + 512 + ch); }
    if (next >= 0) issue_qk(pre, p, next, tid);
    __syncthreads();
    f32x4 aB[8]; zero8(aB);
    wave_gemm128(aB, QS + 16 * w * MP, CX, fr, fq);
    float sum = 0.f;
#pragma unroll
    for (int n = 0; n < 8; ++n) { aI[n] = aI[n] + aF[n] * scf + aB[n] * scb; sum += aI[n][0] + aI[n][1] + aI[n][2] + aI[n][3]; }
    sum += __shfl_xor(sum, 16); sum += __shfl_xor(sum, 32);
    const float mu = sum * (1.f / 128.f);
    float s2 = 0.f;
#pragma unroll
    for (int n = 0; n < 8; ++n) { const f32x4 d = aI[n] - mu; s2 += d[0] * d[0] + d[1] * d[1] + d[2] * d[2] + d[3] * d[3]; }
    s2 += __shfl_xor(s2, 16); s2 += __shfl_xor(s2, 32);
    const float rs = rsqrtf(s2 * (1.f / 128.f) + EPSN);
#pragma unroll
    for (int n = 0; n < 8; ++n) {
        const int ch = hh * 128 + n * 16 + 4 * fq;
        const f32x4 gn = *(const f32x4*)(mhn + ch), sk = *(const f32x4*)(skip + ch);
        const u32x2 xr = xcr[n], orr = ogr[n];
        const f32x4 xc = {bflo(xr[0]), bfhi(xr[0]), bflo(xr[1]), bfhi(xr[1])}, og = {bflo(orr[0]), bfhi(orr[0]), bflo(orr[1]), bfhi(orr[1])};
        f32x4 y;
#pragma unroll
        for (int i = 0; i < 4; ++i) y[i] = ((aI[n][i] - mu) * rs * gn[i] + sk[i] * xc[i]) * sigmoidf_(og[i]);
        u32x2 o; o[0] = pk2(y[0], y[1]); o[1] = pk2(y[2], y[3]);
        *(u32x2*)(ZUV + (T0 + j) * 1024 + 512 + ch) = o;
    }
    __syncthreads();
}

__device__ __forceinline__ void phase_final(const Params& p) {
    const int tid = l_tid(), lane = tid & 63, w = tid >> 6;
    const int gw = l_bid() * 8 + w, NGW = GRID * 8;
    const float* ssq = (const float*)(p.ws + WS_SSQ) + (size_t)6 * T_TOK * 16; const float* g = p.in[26];
    const bf16_t* XB = (const bf16_t*)(p.ws + WS_XB);
    f32x4 gg[4];
#pragma unroll
    for (int j = 0; j < 4; ++j) gg[j] = ((const f32x4*)g)[lane + 64 * j];
    for (int row = gw; row < T_TOK; row += NGW) {
        float s = lane < 16 ? ssq[(size_t)row * 16 + lane] : 0.f;
        s += __shfl_xor(s, 1); s += __shfl_xor(s, 2); s += __shfl_xor(s, 4); s += __shfl_xor(s, 8);
        s = __shfl(s, 0);
        const float rstd = rsqrtf(s * (1.f / DM) + EPSN);
        const u32x2* xb = (const u32x2*)(XB + (size_t)row * DM) + lane;
        f32x4* o = (f32x4*)(p.out + (size_t)row * DM) + lane;
#pragma unroll
        for (int j = 0; j < 4; ++j) { const u32x2 t = xb[64 * j]; o[64 * j] = (f32x4){bflo(t[0]), bfhi(t[0]), bflo(t[1]), bfhi(t[1])} * rstd * gg[j]; }
    }
}

__global__ __launch_bounds__(512, 2) void mega_fwd(Params p) {
    extern __shared__ __attribute__((aligned(16))) unsigned char shm[];
    cg::grid_group grid = cg::this_grid();
    float* ssq = (float*)(p.ws + WS_SSQ);
    bf16_t* XB = (bf16_t*)(p.ws + WS_XB); bf16_t* Hh = (bf16_t*)(p.ws + WS_U);
    bf16_t* ZUV = (bf16_t*)(p.ws + WS_ZUV); bf16_t* ZXO = (bf16_t*)(p.ws + WS_ZXO);
    volatile LAS unsigned* st = (volatile LAS unsigned*)((PG8_LAS unsigned char*)shm + LDS_MAIN);
    if (threadIdx.x == 0) { st[0] = 0u; st[1] = 0u; st[2] = 0u; st[3] = 0u; }
    __syncthreads();
    XcdBarrier xbar = xcd_barrier_post((unsigned*)(p.ws + WS_BAR), st);
    for (int ph = p.ph_lo; ph < p.ph_hi; ++ph) {
        if (ph >= 1 && ph <= 20 && (ph - 1) % 10 == 4) continue;
        if (ph > p.ph_lo) { if (p.ph_hi > 1000) grid.sync(); else xcd_barrier(xbar); }
        if (ph == 0) { phase_prologue(p, shm); continue; }
        if (ph == 21) { phase_final(p); continue; }
        const int l = (ph - 1) / 10, s = (ph - 1) % 10;
        const unsigned char* wl = p.ws + WS_W + (size_t)l * LW_END;
        const float* ss_a = ssq + (size_t)(3 * l) * T_TOK * 16;
        float* ss_b = ssq + (size_t)(3 * l + 1) * T_TOK * 16;
        float* ss_c = ssq + (size_t)(3 * l + 2) * T_TOK * 16;
        float* ss_d = ssq + (size_t)(3 * l + 3) * T_TOK * 16;
        switch (s) {
        case 0: { EpiUp E{Hh, nullptr, 0}; run_gemm_rs(shm, XB, (const bf16_t*)(wl + LW_GU1), 2 * FF, DM, E, ss_a); } break;
        case 1: { EpiRes<false> E{nullptr, XB, ss_b, 0.5f}; run_gemm(shm, Hh, (const bf16_t*)(wl + LW_D1), DM, FF, E); } break;
        case 2: { EpiWin E{ZUV, ZXO, nullptr, 0}; run_gemm_rs(shm, XB, (const bf16_t*)(wl + LW_IN), 2048, DM, E, ss_b); } break;
        case 3: phase_prep(p, l, shm); asm volatile("s_waitcnt vmcnt(0)" ::: "memory"); __syncthreads(); phase_state(p, shm); break;
        case 4: break;
        case 5: phase_scan_sgu(p, l, shm); break;
        case 6: { QKPre pre; int k = l_bid(); issue_qk(pre, p, k, l_tid());
                  for (; k < 1024; k += GRID) unit_out(p, l, shm, k, pre, k + GRID < 1024 ? k + GRID : -1); } break;
        case 7: { EpiRes<false> E{nullptr, XB, ss_c, 1.0f}; run_gemm(shm, ZUV, (const bf16_t*)(wl + LW_OUT), DM, DM, E); } break;
        case 8: { EpiUp E{Hh, nullptr, 0}; run_gemm_rs(shm, XB, (const bf16_t*)(wl + LW_GU2), 2 * FF, DM, E, ss_c); } break;
        case 9: { EpiRes<false> E{nullptr, XB, ss_d, 0.5f}; run_gemm(shm, Hh, (const bf16_t*)(wl + LW_D2), DM, FF, E); } break;
        }
    }
}

#ifndef ONE_LAUNCH
#define ONE_LAUNCH 1
#endif
extern "C" void kernel_launch(void* const* d_in, const int* in_sizes, int n_in, void* d_out, int out_size, void* d_ws, size_t ws_size, hipStream_t stream) {
    static int grid = 0;
    if (grid == 0) {
        if (n_in != 27 || ws_size < WS_END) { fprintf(stderr, "kernel_launch: unexpected n_in %d or ws_size %zu (need %zu)\n", n_in, ws_size, (size_t)WS_END); grid = -1; return; }
        int dev = 0, cus = 0, per_cu = 0;
        hipGetDevice(&dev);
        hipDeviceGetAttribute(&cus, hipDeviceAttributeMultiprocessorCount, dev);
        if (hipFuncSetAttribute((const void*)mega_fwd, hipFuncAttributeMaxDynamicSharedMemorySize, LDS_BYTES) != hipSuccess) { fprintf(stderr, "kernel_launch: hipFuncSetAttribute failed\n"); grid = -1; return; }
        if (hipOccupancyMaxActiveBlocksPerMultiprocessor(&per_cu, (const void*)mega_fwd, 512, LDS_BYTES) != hipSuccess || per_cu < 1) { fprintf(stderr, "kernel_launch: occupancy query says %d\n", per_cu); per_cu = 1; }
        (void)hipGetLastError();
        grid = cus * per_cu;
        if (grid < GRID) { fprintf(stderr, "kernel_launch: this build needs %d co-resident workgroups, device offers %d\n", GRID, grid); grid = -1; return; }
        grid = GRID;
    }
    if (grid < 0) return;
    (void)hipMemsetAsync((unsigned char*)d_ws + WS_BAR, 0, (size_t)XCD_BAR_WORDS * 4, stream);
    Params p{};
    for (int i = 0; i < 27; ++i) p.in[i] = (const float*)d_in[i];
    p.out = (float*)d_out; p.ws = (unsigned char*)d_ws;
#if ONE_LAUNCH
    p.ph_lo = 0; p.ph_hi = 22;
    void* args[] = {&p};
    hipError_t e = hipLaunchCooperativeKernel((const void*)mega_fwd, dim3(grid), dim3(512), args, LDS_BYTES, stream);
    if (e != hipSuccess) fprintf(stderr, "cooperative launch failed: %s (grid %d)\n", hipGetErrorString(e), grid);
#else
    for (int ph = 0; ph < 22; ++ph) { p.ph_lo = ph; p.ph_hi = ph + 1; hipLaunchKernelGGL(mega_fwd, dim3(grid), dim3(512), LDS_BYTES, stream, p); }
#endif
}
```
